# Optimizing an MI355X kernel written in HIP

```python
import jax, jax.numpy as jnp
from jax import lax
import numpy as np

D_MODEL = 1024
BATCH = 4
SEQ = 8192
DEPTH = 2

D_MIX = D_MODEL
D_CONV = D_MIX // 2
CONV_HEADS = 8
CONV_WIDTH = 3
D_POOL = D_MIX - D_CONV
POOL_WINDOWS = (2, 4, 8, 16)
N_POOL_GROUPS = len(POOL_WINDOWS)
D_POOL_GROUP = D_POOL // N_POOL_GROUPS
D_IN_PROJ = 3 * D_CONV + D_POOL
N_EXPERT_GROUPS = 4
EXPERTS_PER_GROUP = 8
N_EXPERTS = N_EXPERT_GROUPS * EXPERTS_PER_GROUP
TOP_K = 2
D_EXPERT = D_MODEL // 2
EXPERT_BLOCK = 128
D_PLE = 256
DEEPNORM_ALPHA = (2 * DEPTH) ** 0.25
DEEPNORM_BETA = (8 * DEPTH) ** -0.25
LN_EPS = 1e-5

kernel_name = "hybrid_conv_pool_hmoe_encoder"


def _layernorm(x, g, b):
    xf = x.astype(jnp.float32)
    mu = jnp.mean(xf, axis=-1, keepdims=True)
    var = jnp.mean(jnp.square(xf - mu), axis=-1, keepdims=True)
    y = (xf - mu) * lax.rsqrt(var + LN_EPS)
    return (y * g.astype(jnp.float32) + b.astype(jnp.float32)).astype(x.dtype)


def _centred_mean_minus_self(u, window):
    S = u.shape[1]
    left = window // 2
    right = window - 1 - left
    cs = jnp.cumsum(u, axis=1)
    cs0 = jnp.pad(cs, ((0, 0), (1, 0), (0, 0)))
    cs_ext = jnp.pad(cs0, ((0, 0), (left, right), (0, 0)), mode="edge")
    hi = cs_ext[:, window:window + S]
    lo = cs_ext[:, :S]
    t = jnp.arange(S)
    cnt = (jnp.minimum(t + right + 1, S) - jnp.maximum(t - left, 0)).astype(jnp.float32)
    return (hi - lo) / cnt[None, :, None] - u


def _hybrid_mixer(xn, w_in, b_in, conv_w, pool_w, pool_scale, w_o):
    B, S, _ = xn.shape
    z = xn @ w_in + b_in
    h = z[..., :D_CONV]
    gate_b = z[..., D_CONV:2 * D_CONV]
    gate_c = z[..., 2 * D_CONV:3 * D_CONV]
    u = z[..., 3 * D_CONV:]
    v = gate_c * h
    v = lax.conv_general_dilated(
        v, conv_w[:, None, :], window_strides=(1,), padding=((1, 1),),
        dimension_numbers=("NWC", "WIO", "NWC"), feature_group_count=D_CONV)
    y_conv = gate_b * v
    ug = u.astype(jnp.float32).reshape(B, S, N_POOL_GROUPS, D_POOL_GROUP)
    pooled = jnp.stack(
        [_centred_mean_minus_self(ug[:, :, g], w) for g, w in enumerate(POOL_WINDOWS)],
        axis=2).astype(xn.dtype)
    y_pool = jnp.einsum("bsgc,gcd->bsgd", pooled, pool_w).reshape(B, S, D_POOL) * pool_scale
    return jnp.concatenate([y_conv, y_pool], axis=-1) @ w_o


def _hierarchical_moe(xn, w_rg, b_rg, w_re, b_re, w1, w3, w2):
    B, S, D = xn.shape
    N = B * S
    xf = xn.reshape(N, D)
    x32 = xf.astype(jnp.float32)
    g_probs = jax.nn.softmax(x32 @ w_rg.astype(jnp.float32) + b_rg.astype(jnp.float32), axis=-1)
    g_sel = jnp.argmax(g_probs, axis=-1)
    g_w = jnp.take_along_axis(g_probs, g_sel[:, None], axis=1)[:, 0]
    e_logits = jnp.einsum("nd,gde->nge", x32, w_re.astype(jnp.float32)) + b_re.astype(jnp.float32)
    e_logits = jnp.take_along_axis(e_logits, g_sel[:, None, None], axis=1)[:, 0]
    top_val, top_idx = lax.top_k(e_logits, TOP_K)
    top_w = jax.nn.softmax(top_val, axis=-1) * g_w[:, None]
    expert_id = (g_sel[:, None] * EXPERTS_PER_GROUP + top_idx).reshape(-1).astype(jnp.int32)
    token_id = jnp.repeat(jnp.arange(N, dtype=jnp.int32), TOP_K)
    gate_w = top_w.reshape(-1)
    A = N * TOP_K
    n_slots = -(-(A + N_EXPERTS * (EXPERT_BLOCK - 1)) // EXPERT_BLOCK) * EXPERT_BLOCK
    n_blocks = n_slots // EXPERT_BLOCK
    order = jnp.argsort(expert_id)
    e_sorted = expert_id[order]
    counts = jnp.bincount(expert_id, length=N_EXPERTS).astype(jnp.int32)
    start = jnp.cumsum(counts) - counts
    padded = (counts + EXPERT_BLOCK - 1) // EXPERT_BLOCK * EXPERT_BLOCK
    padded_end = jnp.cumsum(padded)
    padded_start = padded_end - padded
    rank = jnp.arange(A, dtype=jnp.int32) - start[e_sorted]
    dest = padded_start[e_sorted] + rank
    slot_token = jnp.full((n_slots,), N, jnp.int32).at[dest].set(token_id[order])
    slot_w = jnp.zeros((n_slots,), jnp.float32).at[dest].set(gate_w[order])
    block_starts = jnp.arange(n_blocks, dtype=jnp.int32) * EXPERT_BLOCK
    block_expert = jnp.minimum(jnp.searchsorted(padded_end, block_starts, side="right"),
                               N_EXPERTS - 1).astype(jnp.int32)
    x_pad = jnp.concatenate([xf, jnp.zeros((1, D), xf.dtype)], axis=0)
    xs = x_pad[slot_token].reshape(n_blocks, EXPERT_BLOCK, D)

    def expert_block(args):
        xb, e = args
        hb = jax.nn.silu(xb @ w1[e]) * (xb @ w3[e])
        return hb @ w2[e]

    ys = lax.map(expert_block, (xs, block_expert)).reshape(n_slots, D)
    ys = ys * slot_w.astype(ys.dtype)[:, None]
    out = jax.ops.segment_sum(ys, slot_token, num_segments=N + 1)[:N]
    return out.reshape(B, S, D)


def setup_inputs(seed: int = 0) -> dict:
    key = jax.random.key(seed)
    ks = jax.random.split(key, 32)
    L, D = DEPTH, D_MODEL

    def nrm(k, shape, scale):
        return jax.random.normal(k, shape, jnp.float32) * scale

    return {
        "x": nrm(ks[0], (BATCH, SEQ, D), 1.0),
        "p": nrm(ks[1], (DEPTH, BATCH, SEQ, D_PLE), 1.0),
        "ln0_g": 1.0 + nrm(ks[2], (D,), 0.02),
        "ln0_b": nrm(ks[3], (D,), 0.02),
        "w_in": nrm(ks[4], (L, D, D_IN_PROJ), D ** -0.5),
        "b_in": nrm(ks[5], (L, D_IN_PROJ), 0.02),
        "conv_w": nrm(ks[6], (L, CONV_WIDTH, D_CONV), CONV_WIDTH ** -0.5),
        "pool_w": nrm(ks[7], (L, N_POOL_GROUPS, D_POOL_GROUP, D_POOL_GROUP), D_POOL_GROUP ** -0.5),
        "pool_scale": 1.0 + nrm(ks[8], (L, D_POOL), 0.02),
        "w_o": nrm(ks[9], (L, D_MIX, D), DEEPNORM_BETA * D_MIX ** -0.5),
        "ln1_g": 1.0 + nrm(ks[10], (L, D), 0.02),
        "ln1_b": nrm(ks[11], (L, D), 0.02),
        "w_router_group": nrm(ks[12], (L, D, N_EXPERT_GROUPS), D ** -0.5),
        "b_router_group": nrm(ks[13], (L, N_EXPERT_GROUPS), 0.01),
        "w_router_expert": nrm(ks[14], (L, N_EXPERT_GROUPS, D, EXPERTS_PER_GROUP), D ** -0.5),
        "b_router_expert": nrm(ks[15], (L, N_EXPERT_GROUPS, EXPERTS_PER_GROUP), 0.01),
        "w1": nrm(ks[16], (L, N_EXPERTS, D, D_EXPERT), D ** -0.5),
        "w3": nrm(ks[17], (L, N_EXPERTS, D, D_EXPERT), D ** -0.5),
        "w2": nrm(ks[18], (L, N_EXPERTS, D_EXPERT, D), DEEPNORM_BETA * D_EXPERT ** -0.5),
        "w_ple_gate": nrm(ks[19], (L, D, D), D ** -0.5),
        "b_ple_gate": nrm(ks[20], (L, D), 0.02),
        "w_ple_proj": nrm(ks[21], (L, D_PLE, D), DEEPNORM_BETA * D_PLE ** -0.5),
        "ln2_g": 1.0 + nrm(ks[22], (L, D), 0.02),
        "ln2_b": nrm(ks[23], (L, D), 0.02),
    }


def reference(x, p, ln0_g, ln0_b, w_in, b_in, conv_w, pool_w, pool_scale, w_o,
              ln1_g, ln1_b, w_router_group, b_router_group, w_router_expert,
              b_router_expert, w1, w3, w2, w_ple_gate, b_ple_gate, w_ple_proj,
              ln2_g, ln2_b):
    x = _layernorm(x, ln0_g, ln0_b)
    for i in range(DEPTH):
        mix = _hybrid_mixer(x, w_in[i], b_in[i], conv_w[i], pool_w[i], pool_scale[i], w_o[i])
        x = _layernorm(DEEPNORM_ALPHA * x + mix, ln1_g[i], ln1_b[i])
        ffn = _hierarchical_moe(x, w_router_group[i], b_router_group[i], w_router_expert[i],
                                b_router_expert[i], w1[i], w3[i], w2[i])
        ple = jax.nn.sigmoid(x @ w_ple_gate[i] + b_ple_gate[i]) * (p[i] @ w_ple_proj[i])
        x = _layernorm(DEEPNORM_ALPHA * x + ffn + ple, ln2_g[i], ln2_b[i])
    return x
```

```cpp
#include <hip/hip_runtime.h>
#include <stdio.h>

#define LAS __attribute__((address_space(3)))
typedef unsigned short bf16;
typedef short bf16x8 __attribute__((ext_vector_type(8)));
typedef float f32x4 __attribute__((ext_vector_type(4)));
typedef unsigned v4u __attribute__((ext_vector_type(4)));
typedef unsigned v2u __attribute__((ext_vector_type(2)));

constexpr int NTOK = 32768, SEQ = 8192, D = 1024, DZ = 1536, DIN = 2048, DPLE = 256, DEXP = 512, NEXP = 32, LCAP = 32768;
constexpr int MAXTILES = 288;
constexpr float ALPHA = 1.41421356237309515f;
constexpr float LN_EPS = 1e-5f;

constexpr size_t MiB = 1u << 20;
constexpr size_t WS_CTL = 0, CTL_BYTES = 1 * MiB;
constexpr size_t WS_SMALLW = 4 * MiB;
constexpr size_t SW_LAYER = 10 * MiB, SW_WIN = 0, SW_WO = 4 * MiB, SW_WG = 6 * MiB, SW_WP = 8 * MiB, SW_PW = 8 * MiB + 512 * 1024, SW_BIN = 8 * MiB + 768 * 1024;
constexpr size_t WS_WUP = 24 * MiB, WS_WDN = 88 * MiB;
constexpr size_t WS_XH0 = 120 * MiB, WS_XH1 = 184 * MiB;
constexpr size_t WS_PB = 248 * MiB;
constexpr size_t WS_PP = 280 * MiB;
constexpr size_t WS_LIST = 344 * MiB, WS_LW = 348 * MiB, WS_TOKREC = 352 * MiB;
constexpr size_t WS_H = 354 * MiB, WS_YS = 426 * MiB;
constexpr size_t WS_A2 = WS_H, WS_Z = WS_YS;
constexpr size_t WS_PO = 570 * MiB;
constexpr size_t WS_END = 602 * MiB;
constexpr int CW_CNT = 1024;

__device__ __forceinline__ unsigned f2bf(float f) { unsigned u = __builtin_bit_cast(unsigned, f); return (u + 0x7fffu + ((u >> 16) & 1u)) >> 16; }
__device__ __forceinline__ unsigned pk2(float lo, float hi) { return f2bf(lo) | (f2bf(hi) << 16); }
__device__ __forceinline__ float bf2f(bf16 b) { return __builtin_bit_cast(float, ((unsigned)b) << 16); }
__device__ __forceinline__ float wave_sum(float v) {
#pragma unroll
    for (int o = 1; o < 64; o <<= 1) v += __shfl_xor(v, o);
    return v;
}
#define LDS_WAIT() asm volatile("s_waitcnt lgkmcnt(0)" ::: "memory")

struct Params {
    const float* in[24];
    float* out;
    unsigned char* ws;
    int layer, pad;
};
enum { I_X = 0, I_P, I_LN0G, I_LN0B, I_WIN, I_BIN, I_CONVW, I_POOLW, I_PSCALE, I_WO, I_LN1G, I_LN1B, I_WRG, I_BRG, I_WRE, I_BRE, I_W1, I_W3, I_W2, I_WG, I_BG, I_WP, I_LN2G, I_LN2B };

__device__ __forceinline__ void transpose_item(const float* W, int ldw, int k0, int n0, bf16* WT, int ldt, int drow0, LAS float* scr, int lane) {
#pragma unroll 8
    for (int i = 0; i < 32; ++i) { const int kk = 2 * i + (lane >> 5); scr[kk * 33 + (lane & 31)] = W[(size_t)(k0 + kk) * ldw + n0 + (lane & 31)]; }
    LDS_WAIT(); asm volatile("" ::: "memory");
    const int c = lane & 7;
#pragma unroll
    for (int j = 0; j < 4; ++j) { const int n = (lane >> 3) + 8 * j; const LAS float* s = scr + (8 * c) * 33 + n;
        v4u o; o.x = pk2(s[0 * 33], s[1 * 33]); o.y = pk2(s[2 * 33], s[3 * 33]); o.z = pk2(s[4 * 33], s[5 * 33]); o.w = pk2(s[6 * 33], s[7 * 33]);
        *(v4u*)(WT + (size_t)(drow0 + n) * ldt + k0 + 8 * c) = o; }
    LDS_WAIT(); asm volatile("" ::: "memory");
}
__device__ __forceinline__ int pair_row(int c) { return 256 * (c >> 7) + (c & 127); }

__device__ __forceinline__ void phase_cvt_small(const Params& p, LAS float* scr, int gw, int NGW, int lane) {
    constexpr int I_IN = 16 * 64, I_O = 16 * 32, I_G = 16 * 32, I_PJ = 4 * 32, I_PL = 4 * 8, PER = I_IN + I_O + I_G + I_PJ + I_PL;
    for (int it = gw; it < 2 * PER; it += NGW) {
        const int l = it / PER; int r = it % PER;
        unsigned char* sw = p.ws + WS_SMALLW + (size_t)l * SW_LAYER;
        if (r < I_IN) { const int kb = r / 64, nb = r % 64, n0 = 32 * nb; const int reg = n0 >> 9, cc = n0 & 511;
            const int drow = reg == 0 ? pair_row(cc) : reg == 1 ? 1024 + cc : reg == 2 ? pair_row(cc) + 128 : 1536 + cc;
            transpose_item(p.in[I_WIN] + (size_t)l * D * DIN, DIN, 64 * kb, n0, (bf16*)(sw + SW_WIN), D, drow, scr, lane); continue; }
        r -= I_IN;
        if (r < I_O) { const int kb = r / 32, nb = r % 32; transpose_item(p.in[I_WO] + (size_t)l * D * D, D, 64 * kb, 32 * nb, (bf16*)(sw + SW_WO), D, 32 * nb, scr, lane); continue; }
        r -= I_O;
        if (r < I_G) { const int kb = r / 32, nb = r % 32; transpose_item(p.in[I_WG] + (size_t)l * D * D, D, 64 * kb, 32 * nb, (bf16*)(sw + SW_WG), D, 32 * nb, scr, lane); continue; }
        r -= I_G;
        if (r < I_PJ) { const int kb = r / 32, nb = r % 32; transpose_item(p.in[I_WP] + (size_t)l * DPLE * D, D, 64 * kb, 32 * nb, (bf16*)(sw + SW_WP), DPLE, 32 * nb, scr, lane); continue; }
        r -= I_PJ;
        { const int g = r / 8, q = r % 8, kb = q / 4, nb = q % 4;
          transpose_item(p.in[I_POOLW] + ((size_t)l * 4 + g) * 128 * 128, 128, 64 * kb, 32 * nb, (bf16*)(sw + SW_PW) + (size_t)g * 128 * 128, 128, 32 * nb, scr, lane); }
    }
    for (int i = gw * 64 + lane; i < 2 * DIN; i += NGW * 64) {
        const int l = i / DIN, n = i % DIN; int src;
        if (n < 1024) { const int t = n >> 8, h = (n >> 7) & 1, j = n & 127; src = (h ? 1024 : 0) + 128 * t + j; } else if (n < 1536) src = n - 512; else src = n;
        ((float*)(p.ws + WS_SMALLW + (size_t)l * SW_LAYER + SW_BIN))[n] = p.in[I_BIN][(size_t)l * DIN + src];
    }
}
__device__ __forceinline__ void phase_cvt_moe(const Params& p, int l, LAS float* scr, int gw, int NGW, int lane) {
    bf16* WUP = (bf16*)(p.ws + WS_WUP); bf16* WDN = (bf16*)(p.ws + WS_WDN);
    for (int it = gw; it < NEXP * 768; it += NGW) {
        const int e = it / 768; int r = it % 768;
        const size_t eo = ((size_t)l * NEXP + e);
        if (r < 256) { const int kb = r / 16, nb = r % 16; transpose_item(p.in[I_W1] + eo * D * DEXP, DEXP, 64 * kb, 32 * nb, WUP + (size_t)e * 1024 * 1024, D, pair_row(32 * nb), scr, lane); continue; }
        r -= 256;
        if (r < 256) { const int kb = r / 16, nb = r % 16; transpose_item(p.in[I_W3] + eo * D * DEXP, DEXP, 64 * kb, 32 * nb, WUP + (size_t)e * 1024 * 1024, D, pair_row(32 * nb) + 128, scr, lane); continue; }
        r -= 256;
        { const int kb = r / 32, nb = r % 32; transpose_item(p.in[I_W2] + eo * DEXP * D, D, 64 * kb, 32 * nb, WDN + (size_t)e * 1024 * 512, DEXP, 32 * nb, scr, lane); }
    }
}
__device__ __forceinline__ void ln_row(const float* xrow, const float* g, const float* b, float* orow, bf16* hrow, int lane) {
    const f32x4* xr = (const f32x4*)xrow + lane;
    f32x4 v[4]; float s = 0.f;
#pragma unroll
    for (int j = 0; j < 4; ++j) { v[j] = xr[64 * j]; s += (v[j].x + v[j].y) + (v[j].z + v[j].w); }
    const float mean = wave_sum(s) * (1.f / D); float s2 = 0.f;
#pragma unroll
    for (int j = 0; j < 4; ++j) { v[j] = v[j] - mean; s2 += (v[j].x * v[j].x + v[j].y * v[j].y) + (v[j].z * v[j].z + v[j].w * v[j].w); }
    const float rstd = 1.f / sqrtf(wave_sum(s2) * (1.f / D) + LN_EPS);
#pragma unroll
    for (int j = 0; j < 4; ++j) { const f32x4 gg = ((const f32x4*)g)[lane + 64 * j], bb = ((const f32x4*)b)[lane + 64 * j];
        const f32x4 o = v[j] * rstd * gg + bb;
        ((f32x4*)orow)[lane + 64 * j] = o;
        v2u w; w.x = pk2(o.x, o.y); w.y = pk2(o.z, o.w); ((v2u*)hrow)[lane + 64 * j] = w; }
}
__device__ __forceinline__ void phase_ln0_p(const Params& p, int gw, int NGW, int lane) {
    bf16* XH0 = (bf16*)(p.ws + WS_XH0);
    for (int m = gw; m < NTOK; m += NGW) ln_row(p.in[I_X] + (size_t)m * D, p.in[I_LN0G], p.in[I_LN0B], p.out + (size_t)m * D, XH0 + (size_t)m * D, lane);
    bf16* PB = (bf16*)(p.ws + WS_PB);
    for (size_t i = (size_t)gw * 64 + lane; i < (size_t)2 * NTOK * DPLE / 8; i += (size_t)NGW * 64) {
        const f32x4 a = ((const f32x4*)p.in[I_P])[2 * i], b = ((const f32x4*)p.in[I_P])[2 * i + 1];
        v4u o; o.x = pk2(a.x, a.y); o.y = pk2(a.z, a.w); o.z = pk2(b.x, b.y); o.w = pk2(b.z, b.w); ((v4u*)PB)[i] = o; }
}

__device__ __forceinline__ void route_token(const Params& p, int l, int tok, int lane) {
    const float* xrow = p.out + (size_t)tok * D;
    const float* wrg = p.in[I_WRG] + (size_t)l * D * 4;
    const float* wre = p.in[I_WRE] + (size_t)l * 4 * D * 8;
    float xg[4] = {0.f, 0.f, 0.f, 0.f};
    float xv[16];
#pragma unroll
    for (int j = 0; j < 4; ++j) { const f32x4 t = ((const f32x4*)xrow)[lane + 64 * j]; xv[4 * j] = t.x; xv[4 * j + 1] = t.y; xv[4 * j + 2] = t.z; xv[4 * j + 3] = t.w; }
#pragma unroll
    for (int j = 0; j < 4; ++j)
#pragma unroll
        for (int i = 0; i < 4; ++i) { const int k = 4 * lane + 256 * j + i; const f32x4 w = *(const f32x4*)(wrg + (size_t)k * 4);
            xg[0] += xv[4 * j + i] * w.x; xg[1] += xv[4 * j + i] * w.y; xg[2] += xv[4 * j + i] * w.z; xg[3] += xv[4 * j + i] * w.w; }
    float lg[4];
#pragma unroll
    for (int g = 0; g < 4; ++g) lg[g] = wave_sum(xg[g]) + p.in[I_BRG][l * 4 + g];
    int gs = 0; float gm = lg[0];
#pragma unroll
    for (int g = 1; g < 4; ++g) if (lg[g] > gm) { gm = lg[g]; gs = g; }
    float den = 0.f;
#pragma unroll
    for (int g = 0; g < 4; ++g) den += __expf(lg[g] - gm);
    const float g_w = 1.f / den;
    float el[8] = {0.f, 0.f, 0.f, 0.f, 0.f, 0.f, 0.f, 0.f};
    const float* we = wre + (size_t)gs * D * 8;
#pragma unroll
    for (int j = 0; j < 4; ++j)
#pragma unroll
        for (int i = 0; i < 4; ++i) { const int k = 4 * lane + 256 * j + i; const f32x4 w0 = *(const f32x4*)(we + (size_t)k * 8), w1 = *(const f32x4*)(we + (size_t)k * 8 + 4); const float xx = xv[4 * j + i];
            el[0] += xx * w0.x; el[1] += xx * w0.y; el[2] += xx * w0.z; el[3] += xx * w0.w; el[4] += xx * w1.x; el[5] += xx * w1.y; el[6] += xx * w1.z; el[7] += xx * w1.w; }
#pragma unroll
    for (int e = 0; e < 8; ++e) el[e] = wave_sum(el[e]) + p.in[I_BRE][(l * 4 + gs) * 8 + e];
    int i0 = 0; float v0 = el[0];
#pragma unroll
    for (int e = 1; e < 8; ++e) if (el[e] > v0) { v0 = el[e]; i0 = e; }
    int i1 = -1; float v1 = -3.0e38f;
#pragma unroll
    for (int e = 0; e < 8; ++e) if (e != i0 && el[e] > v1) { v1 = el[e]; i1 = e; }
    const float ex = __expf(v1 - v0); const float w0 = g_w / (1.f + ex), w1 = g_w * ex / (1.f + ex);
    if (lane == 0) {
        unsigned* cnt = (unsigned*)(p.ws + WS_CTL) + CW_CNT + 64 * l;
        const int e0 = gs * 8 + i0, e1 = gs * 8 + i1;
        const unsigned r0 = atomicAdd(cnt + e0, 1u), r1 = atomicAdd(cnt + e1, 1u);
        int* list = (int*)(p.ws + WS_LIST); float* lw = (float*)(p.ws + WS_LW);
        list[(size_t)e0 * LCAP + r0] = tok; lw[(size_t)e0 * LCAP + r0] = w0;
        list[(size_t)e1 * LCAP + r1] = tok; lw[(size_t)e1 * LCAP + r1] = w1;
        int4 rec; rec.x = e0; rec.y = (int)r0; rec.z = e1; rec.w = (int)r1; ((int4*)(p.ws + WS_TOKREC))[tok] = rec;
    }
}

template <int OP> __global__ void __launch_bounds__(256) k_thin(Params p) {
    __shared__ __attribute__((aligned(16))) float scr_all[4 * 64 * 33];
    const int lane = threadIdx.x & 63, w = threadIdx.x >> 6, gw = blockIdx.x * 4 + w, NGW = gridDim.x * 4;
    LAS float* scr = (LAS float*)scr_all + w * 64 * 33;
    if (OP == 0) phase_cvt_small(p, scr, gw, NGW, lane);
    if (OP == 1) phase_cvt_moe(p, p.layer, scr, gw, NGW, lane);
    if (OP == 2) phase_ln0_p(p, gw, NGW, lane);
    if (OP == 3) { for (int t = gw; t < NTOK; t += NGW) route_token(p, p.layer, t, lane); }
    if (OP == 4) {
        const int l = p.layer; bf16* XH = (bf16*)(p.ws + WS_XH1);
        for (int m = gw; m < NTOK; m += NGW) ln_row(p.out + (size_t)m * D, p.in[I_LN1G] + l * D, p.in[I_LN1B] + l * D, p.out + (size_t)m * D, XH + (size_t)m * D, lane);
    }
    if (OP == 5) {
        const int l = p.layer; bf16* XH = (bf16*)(p.ws + WS_XH0);
        for (int m = gw; m < NTOK; m += NGW) ln_row(p.out + (size_t)m * D, p.in[I_LN2G] + l * D, p.in[I_LN2B] + l * D, p.out + (size_t)m * D, XH + (size_t)m * D, lane);
    }
}

template <int NB> __device__ __forceinline__ void wave_mma(const bf16* a0, const bf16* a1, const bf16* (&b)[NB], int K, f32x4 (&acc)[2][NB]) {
#pragma unroll
    for (int i = 0; i < 2; ++i)
#pragma unroll
        for (int j = 0; j < NB; ++j) acc[i][j] = (f32x4){0.f, 0.f, 0.f, 0.f};
    for (int k = 0; k < K; k += 32) {
        const bf16x8 A0 = *(const bf16x8*)(a0 + k), A1 = *(const bf16x8*)(a1 + k);
#pragma unroll
        for (int j = 0; j < NB; ++j) { const bf16x8 B = *(const bf16x8*)(b[j] + k);
            acc[0][j] = __builtin_amdgcn_mfma_f32_16x16x32_bf16(A0, B, acc[0][j], 0, 0, 0);
            acc[1][j] = __builtin_amdgcn_mfma_f32_16x16x32_bf16(A1, B, acc[1][j], 0, 0, 0); }
    }
}
#define WAVE_IDS const int lane = threadIdx.x & 63, fr = lane & 15, fq = lane >> 4, gw = blockIdx.x * 4 + (threadIdx.x >> 6), NGW = gridDim.x * 4; (void)gw; (void)NGW; (void)fr; (void)fq;

__global__ void __launch_bounds__(256) k_n_inproj(Params p) {
    WAVE_IDS
    const int l = p.layer; const bf16* XH = (const bf16*)(p.ws + WS_XH0);
    const bf16* WIN = (const bf16*)(p.ws + WS_SMALLW + (size_t)l * SW_LAYER + SW_WIN); const float* BIN = (const float*)(p.ws + WS_SMALLW + (size_t)l * SW_LAYER + SW_BIN);
    bf16* Z = (bf16*)(p.ws + WS_Z);
    constexpr int NCB = DZ / 32;
    for (int tile = gw; tile < (NTOK / 32) * NCB; tile += NGW) {
        const int r0 = (tile / NCB) * 32, zc0 = (tile % NCB) * 32;
        const bf16* a0 = XH + (size_t)(r0 + fr) * D + 8 * fq; const bf16* a1 = a0 + 16 * D;
        if (zc0 < 512) {
            const int hrow0 = pair_row(zc0);
            const bf16* b[4]; b[0] = WIN + (size_t)(hrow0 + fr) * D + 8 * fq; b[1] = b[0] + 16 * D; b[2] = b[0] + 128 * D; b[3] = b[2] + 16 * D;
            f32x4 acc[2][4]; wave_mma<4>(a0, a1, b, D, acc);
#pragma unroll
            for (int i = 0; i < 2; ++i)
#pragma unroll
                for (int j = 0; j < 2; ++j)
#pragma unroll
                    for (int r = 0; r < 4; ++r) { const int row = r0 + 16 * i + 4 * fq + r, cs = 16 * j + fr;
                        const float hv = acc[i][j][r] + BIN[hrow0 + cs], gv = acc[i][j + 2][r] + BIN[hrow0 + 128 + cs];
                        Z[(size_t)row * DZ + zc0 + cs] = (bf16)f2bf(hv * gv); }
        } else {
            const int brow0 = zc0 + 512;
            const bf16* b[2]; b[0] = WIN + (size_t)(brow0 + fr) * D + 8 * fq; b[1] = b[0] + 16 * D;
            f32x4 acc[2][2]; wave_mma<2>(a0, a1, b, D, acc);
#pragma unroll
            for (int i = 0; i < 2; ++i)
#pragma unroll
                for (int j = 0; j < 2; ++j)
#pragma unroll
                    for (int r = 0; r < 4; ++r) { const int row = r0 + 16 * i + 4 * fq + r, cs = 16 * j + fr;
                        Z[(size_t)row * DZ + zc0 + cs] = (bf16)f2bf(acc[i][j][r] + BIN[brow0 + cs]); }
        }
    }
}
__global__ void __launch_bounds__(256) k_n_mix(Params p) {
    const int l = p.layer; const bf16* Z = (const bf16*)(p.ws + WS_Z); bf16* A2 = (bf16*)(p.ws + WS_A2); bf16* PO = (bf16*)(p.ws + WS_PO);
    const float* cw = p.in[I_CONVW] + (size_t)l * 3 * 512;
    for (size_t i = (size_t)blockIdx.x * 256 + threadIdx.x; i < (size_t)NTOK * 512; i += (size_t)gridDim.x * 256) {
        const int t = (int)(i >> 9), c = (int)(i & 511), tt = t & (SEQ - 1);
        const float vm = tt > 0 ? bf2f(Z[(size_t)(t - 1) * DZ + c]) : 0.f, v0 = bf2f(Z[(size_t)t * DZ + c]), vp = tt < SEQ - 1 ? bf2f(Z[(size_t)(t + 1) * DZ + c]) : 0.f;
        const float gb = bf2f(Z[(size_t)t * DZ + 512 + c]);
        A2[(size_t)t * D + c] = (bf16)f2bf(gb * (cw[c] * vm + cw[512 + c] * v0 + cw[1024 + c] * vp));
        const int g = c >> 7, w = 2 << g, left = w >> 1, right = w - 1 - left;
        const int lo = tt - left < 0 ? 0 : tt - left, hi = tt + right > SEQ - 1 ? SEQ - 1 : tt + right;
        float s = 0.f; const size_t base = (size_t)(t - tt) * DZ + 1024 + c;
        for (int q = lo; q <= hi; ++q) s += bf2f(Z[base + (size_t)q * DZ]);
        PO[(size_t)t * 512 + c] = (bf16)f2bf(s / (float)(hi - lo + 1) - bf2f(Z[(size_t)t * DZ + 1024 + c]));
    }
}
__global__ void __launch_bounds__(256) k_n_poolgemm(Params p) {
    WAVE_IDS
    const int l = p.layer; const bf16* PO = (const bf16*)(p.ws + WS_PO); const bf16* PW = (const bf16*)(p.ws + WS_SMALLW + (size_t)l * SW_LAYER + SW_PW);
    bf16* A2 = (bf16*)(p.ws + WS_A2); const float* ps = p.in[I_PSCALE] + (size_t)l * 512;
    for (int tile = gw; tile < (NTOK / 32) * 16; tile += NGW) {
        const int r0 = (tile / 16) * 32, g = (tile % 16) / 4, d0 = (tile % 4) * 32;
        const bf16* a0 = PO + (size_t)(r0 + fr) * 512 + 128 * g + 8 * fq; const bf16* a1 = a0 + 16 * 512;
        const bf16* b[2]; b[0] = PW + (size_t)(g * 128 + d0 + fr) * 128 + 8 * fq; b[1] = b[0] + 16 * 128;
        f32x4 acc[2][2]; wave_mma<2>(a0, a1, b, 128, acc);
#pragma unroll
        for (int i = 0; i < 2; ++i)
#pragma unroll
            for (int j = 0; j < 2; ++j)
#pragma unroll
                for (int r = 0; r < 4; ++r) { const int row = r0 + 16 * i + 4 * fq + r, cc = 128 * g + d0 + 16 * j + fr;
                    A2[(size_t)row * D + 512 + cc] = (bf16)f2bf(acc[i][j][r] * ps[cc]); }
    }
}
__global__ void __launch_bounds__(256) k_n_outproj(Params p) {
    WAVE_IDS
    const int l = p.layer; const bf16* A2 = (const bf16*)(p.ws + WS_A2); const bf16* WO = (const bf16*)(p.ws + WS_SMALLW + (size_t)l * SW_LAYER + SW_WO);
    for (int tile = gw; tile < (NTOK / 32) * 32; tile += NGW) {
        const int r0 = (tile / 32) * 32, n0 = (tile % 32) * 32;
        const bf16* a0 = A2 + (size_t)(r0 + fr) * D + 8 * fq; const bf16* a1 = a0 + 16 * D;
        const bf16* b[2]; b[0] = WO + (size_t)(n0 + fr) * D + 8 * fq; b[1] = b[0] + 16 * D;
        f32x4 acc[2][2]; wave_mma<2>(a0, a1, b, D, acc);
#pragma unroll
        for (int i = 0; i < 2; ++i)
#pragma unroll
            for (int j = 0; j < 2; ++j)
#pragma unroll
                for (int r = 0; r < 4; ++r) { float* o = p.out + (size_t)(r0 + 16 * i + 4 * fq + r) * D + n0 + 16 * j + fr; *o = ALPHA * *o + acc[i][j][r]; }
    }
}
__device__ __forceinline__ int find_expert(const unsigned* cnt, int mt, int& tbase_out, int& cnt_out) {
    int tb = 0, e_sel = -1, tb_sel = 0, c_sel = 0;
    for (int e = 0; e < NEXP; ++e) { const int c = (int)cnt[e], nt = (c + 255) >> 8; if (e_sel < 0 && mt < tb + nt) { e_sel = e; tb_sel = tb; c_sel = c; } tb += nt; }
    tbase_out = tb_sel; cnt_out = c_sel; return e_sel;
}
__device__ __forceinline__ int tile_base_of(const unsigned* cnt, int e) { int tb = 0; for (int q = 0; q < e; ++q) tb += ((int)cnt[q] + 255) >> 8; return tb; }

__global__ void __launch_bounds__(256) k_n_moe_up(Params p) {
    WAVE_IDS
    const int l = p.layer; const unsigned* cnt = (const unsigned*)(p.ws + WS_CTL) + CW_CNT + 64 * l;
    const bf16* XH = (const bf16*)(p.ws + WS_XH1); const bf16* WUP = (const bf16*)(p.ws + WS_WUP); const int* list = (const int*)(p.ws + WS_LIST); bf16* H = (bf16*)(p.ws + WS_H);
    for (int tile = gw; tile < MAXTILES * 8 * 16; tile += NGW) {
        const int mt = tile / 128, rb = (tile / 16) % 8, c0 = (tile % 16) * 32;
        int tb, ce; const int e = find_expert(cnt, mt, tb, ce); if (e < 0) continue;
        const int rank0 = 256 * (mt - tb) + 32 * rb;
        const int rk0 = rank0 + fr, rk1 = rank0 + 16 + fr;
        const int t0 = rk0 < ce ? list[(size_t)e * LCAP + rk0] : 0, t1 = rk1 < ce ? list[(size_t)e * LCAP + rk1] : 0;
        const bf16* a0 = XH + (size_t)t0 * D + 8 * fq; const bf16* a1 = XH + (size_t)t1 * D + 8 * fq;
        const bf16* We = WUP + (size_t)e * 1024 * 1024; const int brow = pair_row(c0);
        const bf16* b[4]; b[0] = We + (size_t)(brow + fr) * D + 8 * fq; b[1] = b[0] + 16 * D; b[2] = b[0] + 128 * D; b[3] = b[2] + 16 * D;
        f32x4 acc[2][4]; wave_mma<4>(a0, a1, b, D, acc);
#pragma unroll
        for (int i = 0; i < 2; ++i)
#pragma unroll
            for (int j = 0; j < 2; ++j)
#pragma unroll
                for (int r = 0; r < 4; ++r) { const int slot = 256 * mt + 32 * rb + 16 * i + 4 * fq + r; const float a = acc[i][j][r], bb = acc[i][j + 2][r];
                    H[(size_t)slot * DEXP + c0 + 16 * j + fr] = (bf16)f2bf(a / (1.f + __expf(-a)) * bb); }
    }
}
__global__ void __launch_bounds__(256) k_n_moe_down(Params p) {
    WAVE_IDS
    const int l = p.layer; const unsigned* cnt = (const unsigned*)(p.ws + WS_CTL) + CW_CNT + 64 * l;
    const bf16* H = (const bf16*)(p.ws + WS_H); const bf16* WDN = (const bf16*)(p.ws + WS_WDN); const float* lw = (const float*)(p.ws + WS_LW); bf16* YS = (bf16*)(p.ws + WS_YS);
    for (int tile = gw; tile < MAXTILES * 8 * 32; tile += NGW) {
        const int mt = tile / 256, rb = (tile / 32) % 8, n0 = (tile % 32) * 32;
        int tb, ce; const int e = find_expert(cnt, mt, tb, ce); if (e < 0) continue;
        const int slot0 = 256 * mt + 32 * rb, rank0 = 256 * (mt - tb) + 32 * rb;
        const bf16* a0 = H + (size_t)(slot0 + fr) * DEXP + 8 * fq; const bf16* a1 = a0 + 16 * DEXP;
        const bf16* We = WDN + (size_t)e * 1024 * 512;
        const bf16* b[2]; b[0] = We + (size_t)(n0 + fr) * DEXP + 8 * fq; b[1] = b[0] + 16 * DEXP;
        f32x4 acc[2][2]; wave_mma<2>(a0, a1, b, DEXP, acc);
#pragma unroll
        for (int i = 0; i < 2; ++i)
#pragma unroll
            for (int r = 0; r < 4; ++r) { const int rr = 16 * i + 4 * fq + r, rank = rank0 + rr; const float w = rank < ce ? lw[(size_t)e * LCAP + rank] : 0.f;
#pragma unroll
                for (int j = 0; j < 2; ++j) YS[(size_t)(slot0 + rr) * D + n0 + 16 * j + fr] = (bf16)f2bf(acc[i][j][r] * w); }
    }
}
__global__ void __launch_bounds__(256) k_n_pp(Params p) {
    WAVE_IDS
    const int l = p.layer; const bf16* PB = (const bf16*)(p.ws + WS_PB) + (size_t)l * NTOK * DPLE; const bf16* WP = (const bf16*)(p.ws + WS_SMALLW + (size_t)l * SW_LAYER + SW_WP); bf16* PP = (bf16*)(p.ws + WS_PP);
    for (int tile = gw; tile < (NTOK / 32) * 32; tile += NGW) {
        const int r0 = (tile / 32) * 32, n0 = (tile % 32) * 32;
        const bf16* a0 = PB + (size_t)(r0 + fr) * DPLE + 8 * fq; const bf16* a1 = a0 + 16 * DPLE;
        const bf16* b[2]; b[0] = WP + (size_t)(n0 + fr) * DPLE + 8 * fq; b[1] = b[0] + 16 * DPLE;
        f32x4 acc[2][2]; wave_mma<2>(a0, a1, b, DPLE, acc);
#pragma unroll
        for (int i = 0; i < 2; ++i)
#pragma unroll
            for (int j = 0; j < 2; ++j)
#pragma unroll
                for (int r = 0; r < 4; ++r) PP[(size_t)(r0 + 16 * i + 4 * fq + r) * D + n0 + 16 * j + fr] = (bf16)f2bf(acc[i][j][r]);
    }
}
__global__ void __launch_bounds__(256) k_n_ple(Params p) {
    WAVE_IDS
    const int l = p.layer; const unsigned* cnt = (const unsigned*)(p.ws + WS_CTL) + CW_CNT + 64 * l;
    const bf16* XH = (const bf16*)(p.ws + WS_XH1); const bf16* WG = (const bf16*)(p.ws + WS_SMALLW + (size_t)l * SW_LAYER + SW_WG); const float* bg = p.in[I_BG] + (size_t)l * D;
    const bf16* PP = (const bf16*)(p.ws + WS_PP); const bf16* YS = (const bf16*)(p.ws + WS_YS); const int4* rec = (const int4*)(p.ws + WS_TOKREC);
    for (int tile = gw; tile < (NTOK / 32) * 32; tile += NGW) {
        const int r0 = (tile / 32) * 32, n0 = (tile % 32) * 32;
        const bf16* a0 = XH + (size_t)(r0 + fr) * D + 8 * fq; const bf16* a1 = a0 + 16 * D;
        const bf16* b[2]; b[0] = WG + (size_t)(n0 + fr) * D + 8 * fq; b[1] = b[0] + 16 * D;
        f32x4 acc[2][2]; wave_mma<2>(a0, a1, b, D, acc);
#pragma unroll
        for (int i = 0; i < 2; ++i)
#pragma unroll
            for (int r = 0; r < 4; ++r) { const int row = r0 + 16 * i + 4 * fq + r; const int4 rc = rec[row];
                const size_t s0 = (size_t)256 * tile_base_of(cnt, rc.x) + rc.y, s1 = (size_t)256 * tile_base_of(cnt, rc.z) + rc.w;
#pragma unroll
                for (int j = 0; j < 2; ++j) { const int col = n0 + 16 * j + fr; const float g = acc[i][j][r] + bg[col]; const float sg = 1.f / (1.f + __expf(-g));
                    float* o = p.out + (size_t)row * D + col;
                    *o = ALPHA * *o + bf2f(YS[s0 * D + col]) + bf2f(YS[s1 * D + col]) + sg * bf2f(PP[(size_t)row * D + col]); } }
    }
}

extern "C" void kernel_launch(void* const* d_in, const int* in_sizes, int n_in, void* d_out, int out_size, void* d_ws, size_t ws_size, hipStream_t stream) {
    if (n_in != 24 || in_sizes[0] != NTOK * D || out_size != NTOK * D || ws_size < WS_END) {
        fprintf(stderr, "kernel_launch: unexpected shapes (n_in %d, in0 %d, out %d, ws %zu < %zu); nothing launched\n", n_in, n_in > 0 ? in_sizes[0] : -1, out_size, ws_size, (size_t)WS_END); return; }
    (void)hipMemsetAsync((char*)d_ws + WS_CTL, 0, CTL_BYTES, stream);
    Params p{};
    for (int i = 0; i < 24; ++i) p.in[i] = (const float*)d_in[i];
    p.out = (float*)d_out; p.ws = (unsigned char*)d_ws; p.layer = 0; p.pad = 0;
    const dim3 blk(256); const dim3 grd(2048);
    hipLaunchKernelGGL(k_thin<0>, grd, blk, 0, stream, p);
    hipLaunchKernelGGL(k_thin<2>, grd, blk, 0, stream, p);
    for (int l = 0; l < 2; ++l) {
        p.layer = l;
        hipLaunchKernelGGL(k_thin<1>, grd, blk, 0, stream, p);
        hipLaunchKernelGGL(k_n_inproj, grd, blk, 0, stream, p);
        hipLaunchKernelGGL(k_n_mix, grd, blk, 0, stream, p);
        hipLaunchKernelGGL(k_n_poolgemm, grd, blk, 0, stream, p);
        hipLaunchKernelGGL(k_n_outproj, grd, blk, 0, stream, p);
        hipLaunchKernelGGL(k_thin<4>, grd, blk, 0, stream, p);
        hipLaunchKernelGGL(k_thin<3>, grd, blk, 0, stream, p);
        hipLaunchKernelGGL(k_n_moe_up, grd, blk, 0, stream, p);
        hipLaunchKernelGGL(k_n_moe_down, grd, blk, 0, stream, p);
        hipLaunchKernelGGL(k_n_pp, grd, blk, 0, stream, p);
        hipLaunchKernelGGL(k_n_ple, grd, blk, 0, stream, p);
        hipLaunchKernelGGL(k_thin<5>, grd, blk, 0, stream, p);
    }
}
```

```cpp
#include <hip/hip_runtime.h>
#include <stdio.h>

#define LAS __attribute__((address_space(3)))
typedef unsigned short bf16;
typedef short bf16x8 __attribute__((ext_vector_type(8)));
typedef float f32x4 __attribute__((ext_vector_type(4)));
typedef unsigned v4u __attribute__((ext_vector_type(4)));
typedef unsigned v2u __attribute__((ext_vector_type(2)));

constexpr int NTOK = 32768, SEQ = 8192, D = 1024, DZ = 1536, DIN = 2048, DPLE = 256, DEXP = 512, NEXP = 32, LCAP = 32768;
constexpr int MAXTILES = 288;
constexpr float ALPHA = 1.41421356237309515f;
constexpr float LN_EPS = 1e-5f;

constexpr size_t MiB = 1u << 20;
constexpr size_t WS_CTL = 0, CTL_BYTES = 1 * MiB;
constexpr size_t WS_SMALLW = 4 * MiB;
constexpr size_t SW_LAYER = 10 * MiB, SW_WIN = 0, SW_WO = 4 * MiB, SW_WG = 6 * MiB, SW_WP = 8 * MiB, SW_PW = 8 * MiB + 512 * 1024, SW_BIN = 8 * MiB + 768 * 1024, SW_WR = 9 * MiB;
constexpr size_t WS_WUP = 24 * MiB, WS_WDN = 88 * MiB;
constexpr size_t WS_XH0 = 120 * MiB, WS_XH1 = 184 * MiB;
constexpr size_t WS_PB = 248 * MiB;
constexpr size_t WS_PP = 280 * MiB;
constexpr size_t WS_LIST = 344 * MiB, WS_LW = 348 * MiB, WS_TOKREC = 352 * MiB;
constexpr size_t WS_TOKW = 352 * MiB + 512 * 1024, WS_HIST = 353 * MiB;
constexpr size_t WS_H = 354 * MiB, WS_YS = 426 * MiB;
constexpr size_t WS_A2 = WS_H, WS_Z = WS_YS;
constexpr size_t WS_PO = 570 * MiB;
constexpr size_t WS_END = 602 * MiB;
constexpr int CW_CNT = 1024;

__device__ __forceinline__ unsigned f2bf(float f) { unsigned u = __builtin_bit_cast(unsigned, f); return (u + 0x7fffu + ((u >> 16) & 1u)) >> 16; }
__device__ __forceinline__ unsigned pk2(float lo, float hi) { return f2bf(lo) | (f2bf(hi) << 16); }
__device__ __forceinline__ float bf2f(bf16 b) { return __builtin_bit_cast(float, ((unsigned)b) << 16); }
__device__ __forceinline__ float wave_sum(float v) {
#pragma unroll
    for (int o = 1; o < 64; o <<= 1) v += __shfl_xor(v, o);
    return v;
}
#define LDS_WAIT() asm volatile("s_waitcnt lgkmcnt(0)" ::: "memory")

struct Params {
    const float* in[24];
    float* out;
    unsigned char* ws;
    int layer, ph_lo, ph_hi, pad;
};
enum { I_X = 0, I_P, I_LN0G, I_LN0B, I_WIN, I_BIN, I_CONVW, I_POOLW, I_PSCALE, I_WO, I_LN1G, I_LN1B, I_WRG, I_BRG, I_WRE, I_BRE, I_W1, I_W3, I_W2, I_WG, I_BG, I_WP, I_LN2G, I_LN2B };

constexpr int TSCR_BYTES = 64 * 65 * 4;
__device__ __forceinline__ void transpose_item(const float* W, int ldw, int k0, int n0, bf16* WT, int ldt, int drow0, LAS float* scr, int lane) {
    const int lk = lane >> 4, ln = 4 * (lane & 15);
#pragma unroll
    for (int i = 0; i < 16; ++i) { const int kk = 4 * i + lk; const f32x4 v = *(const f32x4*)(W + (size_t)(k0 + kk) * ldw + n0 + ln);
        LAS float* d = scr + kk * 65 + ln; d[0] = v.x; d[1] = v.y; d[2] = v.z; d[3] = v.w; }
    LDS_WAIT(); asm volatile("" ::: "memory");
    const int c = lane & 7;
#pragma unroll
    for (int j = 0; j < 8; ++j) { const int n = (lane >> 3) + 8 * j; const LAS float* s = scr + (8 * c) * 65 + n;
        v4u o; o.x = pk2(s[0 * 65], s[1 * 65]); o.y = pk2(s[2 * 65], s[3 * 65]); o.z = pk2(s[4 * 65], s[5 * 65]); o.w = pk2(s[6 * 65], s[7 * 65]);
        *(v4u*)(WT + (size_t)(drow0 + n) * ldt + k0 + 8 * c) = o; }
    LDS_WAIT(); asm volatile("" ::: "memory");
}
__device__ __forceinline__ int pair_row(int c) { return 256 * (c >> 7) + (c & 127); }

__device__ __forceinline__ void phase_cvt_small(const Params& p, LAS float* scr, int gw, int NGW, int lane) {
    constexpr int I_IN = 16 * 32, I_O = 16 * 16, I_G = 16 * 16, I_PJ = 4 * 16, I_PL = 4 * 4, PER = I_IN + I_O + I_G + I_PJ + I_PL;
    for (int it = gw; it < 2 * PER; it += NGW) {
        const int l = it / PER; int r = it % PER;
        unsigned char* sw = p.ws + WS_SMALLW + (size_t)l * SW_LAYER;
        if (r < I_IN) { const int kb = r / 32, nb = r % 32, n0 = 64 * nb; const int reg = n0 >> 9, cc = n0 & 511;
            const int drow = reg == 0 ? pair_row(cc) : reg == 1 ? 1024 + cc : reg == 2 ? pair_row(cc) + 128 : 1536 + cc;
            transpose_item(p.in[I_WIN] + (size_t)l * D * DIN, DIN, 64 * kb, n0, (bf16*)(sw + SW_WIN), D, drow, scr, lane); continue; }
        r -= I_IN;
        if (r < I_O) { const int kb = r / 16, nb = r % 16; transpose_item(p.in[I_WO] + (size_t)l * D * D, D, 64 * kb, 64 * nb, (bf16*)(sw + SW_WO), D, 64 * nb, scr, lane); continue; }
        r -= I_O;
        if (r < I_G) { const int kb = r / 16, nb = r % 16; transpose_item(p.in[I_WG] + (size_t)l * D * D, D, 64 * kb, 64 * nb, (bf16*)(sw + SW_WG), D, 64 * nb, scr, lane); continue; }
        r -= I_G;
        if (r < I_PJ) { const int kb = r / 16, nb = r % 16; transpose_item(p.in[I_WP] + (size_t)l * DPLE * D, D, 64 * kb, 64 * nb, (bf16*)(sw + SW_WP), DPLE, 64 * nb, scr, lane); continue; }
        r -= I_PJ;
        { const int g = r / 4, q = r % 4, kb = q / 2, nb = q % 2;
          transpose_item(p.in[I_POOLW] + ((size_t)l * 4 + g) * 128 * 128, 128, 64 * kb, 64 * nb, (bf16*)(sw + SW_PW) + (size_t)g * 128 * 128, 128, 64 * nb, scr, lane); }
    }
    for (int i = gw * 64 + lane; i < 2 * DIN; i += NGW * 64) {
        const int l = i / DIN, n = i % DIN; int src;
        if (n < 1024) { const int t = n >> 8, h = (n >> 7) & 1, j = n & 127; src = (h ? 1024 : 0) + 128 * t + j; } else if (n < 1536) src = n - 512; else src = n;
        ((float*)(p.ws + WS_SMALLW + (size_t)l * SW_LAYER + SW_BIN))[n] = p.in[I_BIN][(size_t)l * DIN + src];
    }
}
__device__ __forceinline__ void phase_cvt_moe(const Params& p, int l, LAS float* scr, int gw, int NGW, int lane) {
    bf16* WUP = (bf16*)(p.ws + WS_WUP); bf16* WDN = (bf16*)(p.ws + WS_WDN);
    for (int it = gw; it < NEXP * 384; it += NGW) {
        const int e = it / 384; int r = it % 384;
        const size_t eo = ((size_t)l * NEXP + e);
        if (r < 128) { const int kb = r / 8, nb = r % 8; transpose_item(p.in[I_W1] + eo * D * DEXP, DEXP, 64 * kb, 64 * nb, WUP + (size_t)e * 1024 * 1024, D, pair_row(64 * nb), scr, lane); continue; }
        r -= 128;
        if (r < 128) { const int kb = r / 8, nb = r % 8; transpose_item(p.in[I_W3] + eo * D * DEXP, DEXP, 64 * kb, 64 * nb, WUP + (size_t)e * 1024 * 1024, D, pair_row(64 * nb) + 128, scr, lane); continue; }
        r -= 128;
        { const int kb = r / 16, nb = r % 16; transpose_item(p.in[I_W2] + eo * DEXP * D, D, 64 * kb, 64 * nb, WDN + (size_t)e * 1024 * 512, DEXP, 64 * nb, scr, lane); }
    }
}
__device__ __forceinline__ void ln_row(const float* xrow, const float* g, const float* b, bf16* hrow, int lane) {
    const f32x4* xr = (const f32x4*)xrow + lane;
    f32x4 v[4]; float s = 0.f;
#pragma unroll
    for (int j = 0; j < 4; ++j) { v[j] = xr[64 * j]; s += (v[j].x + v[j].y) + (v[j].z + v[j].w); }
    const float mean = wave_sum(s) * (1.f / D); float s2 = 0.f;
#pragma unroll
    for (int j = 0; j < 4; ++j) { v[j] = v[j] - mean; s2 += (v[j].x * v[j].x + v[j].y * v[j].y) + (v[j].z * v[j].z + v[j].w * v[j].w); }
    const float rstd = 1.f / sqrtf(wave_sum(s2) * (1.f / D) + LN_EPS);
#pragma unroll
    for (int j = 0; j < 4; ++j) { const f32x4 gg = ((const f32x4*)g)[lane + 64 * j], bb = ((const f32x4*)b)[lane + 64 * j];
        const f32x4 o = v[j] * rstd * gg + bb;
        v2u w; w.x = pk2(o.x, o.y); w.y = pk2(o.z, o.w); ((v2u*)hrow)[lane + 64 * j] = w; }
}
__device__ __forceinline__ void ln_row2(const float* xrow, const float* g, const float* b, bf16* hrow, int lane) {
    const f32x4* xr = (const f32x4*)xrow + lane;
    f32x4 v[2][4]; float s[2] = {0.f, 0.f};
#pragma unroll
    for (int q = 0; q < 2; ++q)
#pragma unroll
        for (int j = 0; j < 4; ++j) v[q][j] = xr[q * (D / 4) + 64 * j];
#pragma unroll
    for (int q = 0; q < 2; ++q) {
#pragma unroll
        for (int j = 0; j < 4; ++j) s[q] += (v[q][j].x + v[q][j].y) + (v[q][j].z + v[q][j].w);
        const float mean = wave_sum(s[q]) * (1.f / D); float s2 = 0.f;
#pragma unroll
        for (int j = 0; j < 4; ++j) { v[q][j] = v[q][j] - mean; s2 += (v[q][j].x * v[q][j].x + v[q][j].y * v[q][j].y) + (v[q][j].z * v[q][j].z + v[q][j].w * v[q][j].w); }
        const float rstd = 1.f / sqrtf(wave_sum(s2) * (1.f / D) + LN_EPS);
#pragma unroll
        for (int j = 0; j < 4; ++j) { const f32x4 gg = ((const f32x4*)g)[lane + 64 * j], bb = ((const f32x4*)b)[lane + 64 * j];
            const f32x4 o = v[q][j] * rstd * gg + bb;
            v2u w; w.x = pk2(o.x, o.y); w.y = pk2(o.z, o.w); ((v2u*)hrow)[q * (D / 4) + lane + 64 * j] = w; } }
}
__device__ __forceinline__ void phase_ln0_p(const Params& p, int gw, int NGW, int lane) {
    bf16* XH0 = (bf16*)(p.ws + WS_XH0);
    for (int m = 2 * gw; m < NTOK; m += 2 * NGW) ln_row2(p.in[I_X] + (size_t)m * D, p.in[I_LN0G], p.in[I_LN0B], XH0 + (size_t)m * D, lane);
    bf16* PB = (bf16*)(p.ws + WS_PB);
    for (size_t i0 = (size_t)gw * 256; i0 < (size_t)2 * NTOK * DPLE / 8; i0 += (size_t)NGW * 256) {
        f32x4 a[4], b[4];
#pragma unroll
        for (int q = 0; q < 4; ++q) { const size_t i = i0 + 64 * q + lane; a[q] = ((const f32x4*)p.in[I_P])[2 * i]; b[q] = ((const f32x4*)p.in[I_P])[2 * i + 1]; }
#pragma unroll
        for (int q = 0; q < 4; ++q) { const size_t i = i0 + 64 * q + lane; v4u o; o.x = pk2(a[q].x, a[q].y); o.y = pk2(a[q].z, a[q].w); o.z = pk2(b[q].x, b[q].y); o.w = pk2(b[q].z, b[q].w); ((v4u*)PB)[i] = o; } }
    for (int i = gw * 64 + lane; i < 2 * 48 * D; i += NGW * 64) {
        const int l = i / (48 * D), n = (i / D) % 48, k = i % D; float w = 0.f;
        if (n < 4) w = p.in[I_WRG][((size_t)l * D + k) * 4 + n]; else if (n < 36) w = p.in[I_WRE][(((size_t)l * 4 + ((n - 4) >> 3)) * D + k) * 8 + ((n - 4) & 7)];
        const unsigned h = f2bf(w); const float r = w - __builtin_bit_cast(float, h << 16);
        bf16* WR = (bf16*)(p.ws + WS_SMALLW + (size_t)l * SW_LAYER + SW_WR); WR[n * D + k] = (bf16)h; WR[48 * D + n * D + k] = (bf16)f2bf(r); }
}

namespace pg8 {
typedef unsigned u32x4 __attribute__((ext_vector_type(4)));
constexpr int BM = 256, BK = 64, HALF = 128, HTB = HALF * BK * 2, STAGE_BYTES = 8 * HTB, NXCD = 8, WGM = 8;
__device__ __forceinline__ int lds_byte(int r, int c) { const int st = (r >> 4) * 2 + (c >> 5), rr = r & 15, cc = c & 31, ob = rr * 64 + cc * 2; return st * 1024 + (ob ^ (((ob >> 9) & 1) << 5)); }
__device__ __forceinline__ void stage_rc(int b, int& R, int& C) { const int st = b / 1024, sb = b % 1024, swz = sb ^ (((sb >> 9) & 1) << 5); R = (st >> 1) * 16 + swz / 64; C = (st & 1) * 32 + (swz % 64) / 2; }
__device__ __forceinline__ int perm32(int rho) { const int n = rho >> 4, i = rho & 15; return 8 * (i >> 2) + 4 * n + (i & 3); }
__device__ __forceinline__ unsigned cvt_pk_bf16(float lo, float hi) { unsigned r; asm volatile("v_cvt_pk_bf16_f32 %0, %1, %2" : "=v"(r) : "v"(lo), "v"(hi)); return r; }

struct Unit { int pm, pn, e, r0, ce; };

struct DenseOrder {
    static constexpr bool GATHER = false;
    int nM, nN, nwg, G, c, K; const char* A; const char* Bt;
    __device__ __forceinline__ void init(const bf16* A_, const bf16* Bt_, int M, int N, int K_, int G_, int c_) { A = (const char*)A_; Bt = (const char*)Bt_; nM = M / BM; nN = N / BM; nwg = nM * nN; G = G_; c = c_; K = K_; }
    __device__ __forceinline__ bool next(int i, Unit& u) const {
        const long L = (long)i * G + c; if (L >= nwg) return false;
        int wgid = (int)L; { const int q = nwg / NXCD, r = nwg % NXCD, xcd = wgid % NXCD, off = wgid / NXCD; wgid = (xcd < r ? xcd * (q + 1) : r * (q + 1) + (xcd - r) * q) + off; }
        const int nig = WGM * nN, gid = wgid / nig, fm = gid * WGM, gsz = (nM - fm) < WGM ? (nM - fm) : WGM;
        u.pm = fm + ((wgid % nig) % gsz); u.pn = (wgid % nig) / gsz; u.e = 0; u.r0 = 0; u.ce = 0; return true;
    }
    __device__ __forceinline__ const char* a_base(const Unit& u) const { return A + (size_t)u.pm * BM * K * 2; }
    __device__ __forceinline__ const char* b_base(const Unit& u) const { return Bt + (size_t)u.pn * BM * K * 2; }
    __device__ __forceinline__ void a_offs(const Unit&, unsigned (&v)[2][2], int) const {}
};
struct ListOrder {
    static constexpr bool GATHER = false;
    int na, ua, ub0, lim, K; const char* A; const char* Bt;
    __device__ __forceinline__ bool next(int i, Unit& u) const {
        int id; if (i < na) id = ua; else { id = ub0 + 256 * (i - na); if (ub0 < 0 || id >= lim) return false; }
        u.pm = id >> 2; u.pn = id & 3; u.e = 0; u.r0 = 0; u.ce = 0; return true;
    }
    __device__ __forceinline__ const char* a_base(const Unit& u) const { return A + (size_t)u.pm * BM * K * 2; }
    __device__ __forceinline__ const char* b_base(const Unit& u) const { return Bt + (size_t)u.pn * BM * K * 2; }
    __device__ __forceinline__ void a_offs(const Unit&, unsigned (&v)[2][2], int) const {}
};
template <bool GATHER_> struct MoeOrder {
    static constexpr bool GATHER = GATHER_;
    const LAS int* tb; const LAS int* ct; const LAS int* t2e;
    int T4, G, c, K; const char* A; const char* W; size_t wstride; const int* list;
    __device__ __forceinline__ bool next(int i, Unit& u) const {
        const int L = i * G + c; if (L >= T4) return false;
        const int mt = L >> 2, e = t2e[mt];
        u.pm = mt; u.pn = L & 3; u.e = e; u.r0 = 256 * (mt - tb[e]); u.ce = ct[e]; return true;
    }
    __device__ __forceinline__ const char* a_base(const Unit& u) const { return GATHER ? A : A + (size_t)u.pm * BM * K * 2; }
    __device__ __forceinline__ const char* b_base(const Unit& u) const { return W + (size_t)u.e * wstride + (size_t)u.pn * BM * K * 2; }
    __device__ __forceinline__ void a_offs(const Unit& u, unsigned (&v)[2][2], int tid) const {
#pragma unroll
        for (int i = 0; i < 2; ++i) { int R, C; stage_rc(tid * 16 + i * 8192, R, C);
#pragma unroll
            for (int h = 0; h < 2; ++h) { const int rank = u.r0 + HALF * h + R; const int tok = rank < u.ce ? (list[(size_t)u.e * LCAP + rank] >> 1) : 0;
                v[h][i] = (unsigned)(tok * K + C) * 2u; } } }
};

#define EPI_ARGS const f32x4 (&acc)[2][2][4][2], const Unit& u, int wr, int wc, int fr, int fq
__device__ __forceinline__ u32x4 pack8(const f32x4 v0, const f32x4 v1) { u32x4 w; w.x = cvt_pk_bf16(v0[0], v0[1]); w.y = cvt_pk_bf16(v0[2], v0[3]); w.z = cvt_pk_bf16(v1[0], v1[1]); w.w = cvt_pk_bf16(v1[2], v1[3]); return w; }
__device__ __forceinline__ void unpack4x2(const v4u x, f32x4& lo, f32x4& hi) {
    lo[0] = __uint_as_float(x.x << 16); lo[1] = __uint_as_float(x.x & 0xffff0000u); lo[2] = __uint_as_float(x.y << 16); lo[3] = __uint_as_float(x.y & 0xffff0000u);
    hi[0] = __uint_as_float(x.z << 16); hi[1] = __uint_as_float(x.z & 0xffff0000u); hi[2] = __uint_as_float(x.w << 16); hi[3] = __uint_as_float(x.w & 0xffff0000u); }
struct EpiPlain {
    static constexpr bool PERM = true, AFTER_DRAIN = false;
    bf16* O; int ldc;
    __device__ __forceinline__ void operator()(EPI_ARGS) const {
        const int row0 = u.pm * BM + wr * 64 + fr, col0 = u.pn * BM + wc * 32 + 8 * fq;
#pragma unroll
        for (int ai = 0; ai < 2; ++ai)
#pragma unroll
            for (int m = 0; m < 4; ++m) { bf16* rowp = O + (size_t)(row0 + ai * HALF + m * 16) * ldc + col0;
#pragma unroll
                for (int bj = 0; bj < 2; ++bj) *(u32x4*)(rowp + bj * HALF) = pack8(acc[ai][bj][m][0], acc[ai][bj][m][1]); }
    }
};
struct EpiPairZ {
    static constexpr bool PERM = true, AFTER_DRAIN = false;
    bf16* Z; const float* bias;
    __device__ __forceinline__ void operator()(EPI_ARGS) const {
        const int row0 = u.pm * BM + wr * 64 + fr, bcol0 = u.pn * BM + wc * 32 + 8 * fq;
        f32x4 bv[2][2];
#pragma unroll
        for (int bj = 0; bj < 2; ++bj)
#pragma unroll
            for (int n = 0; n < 2; ++n) bv[bj][n] = *(const f32x4*)(bias + bcol0 + bj * HALF + 4 * n);
        if (u.pn < 4) {
            const int col0 = 128 * u.pn + wc * 32 + 8 * fq;
#pragma unroll
            for (int ai = 0; ai < 2; ++ai)
#pragma unroll
                for (int m = 0; m < 4; ++m) { bf16* rowp = Z + (size_t)(row0 + ai * HALF + m * 16) * DZ + col0;
                    const f32x4 v0 = (acc[ai][0][m][0] + bv[0][0]) * (acc[ai][1][m][0] + bv[1][0]), v1 = (acc[ai][0][m][1] + bv[0][1]) * (acc[ai][1][m][1] + bv[1][1]);
                    *(u32x4*)rowp = pack8(v0, v1); }
        } else {
            const int col0 = 512 + 256 * (u.pn - 4) + wc * 32 + 8 * fq;
#pragma unroll
            for (int ai = 0; ai < 2; ++ai)
#pragma unroll
                for (int m = 0; m < 4; ++m) { bf16* rowp = Z + (size_t)(row0 + ai * HALF + m * 16) * DZ + col0;
#pragma unroll
                    for (int bj = 0; bj < 2; ++bj) *(u32x4*)(rowp + bj * HALF) = pack8(acc[ai][bj][m][0] + bv[bj][0], acc[ai][bj][m][1] + bv[bj][1]); }
        }
    }
};
__device__ __forceinline__ f32x4 silu_mul(const f32x4 a, const f32x4 b) { f32x4 o;
#pragma unroll
    for (int j = 0; j < 4; ++j) o[j] = a[j] * __builtin_amdgcn_rcpf(1.f + __expf(-a[j])) * b[j];
    return o; }
struct EpiUp {
    static constexpr bool PERM = true, AFTER_DRAIN = false;
    bf16* H;
    __device__ __forceinline__ void operator()(EPI_ARGS) const {
        const int row0 = u.pm * BM + wr * 64 + fr, col0 = 128 * u.pn + wc * 32 + 8 * fq;
#pragma unroll
        for (int ai = 0; ai < 2; ++ai)
#pragma unroll
            for (int m = 0; m < 4; ++m) { bf16* rowp = H + (size_t)(row0 + ai * HALF + m * 16) * DEXP + col0;
                *(u32x4*)rowp = pack8(silu_mul(acc[ai][0][m][0], acc[ai][1][m][0]), silu_mul(acc[ai][0][m][1], acc[ai][1][m][1])); }
    }
};
struct EpiGate {
    static constexpr bool PERM = true, AFTER_DRAIN = false;
    bf16* PP; const float* bg;
    __device__ __forceinline__ void operator()(EPI_ARGS) const {
        const int row0 = u.pm * BM + wr * 64 + fr, col0 = u.pn * BM + wc * 32 + 8 * fq;
        f32x4 bv[2][2];
#pragma unroll
        for (int bj = 0; bj < 2; ++bj)
#pragma unroll
            for (int n = 0; n < 2; ++n) bv[bj][n] = *(const f32x4*)(bg + col0 + bj * HALF + 4 * n);
#pragma unroll
        for (int ai = 0; ai < 2; ++ai) {
            v4u pv[4][2];
#pragma unroll
            for (int m = 0; m < 4; ++m)
#pragma unroll
                for (int bj = 0; bj < 2; ++bj) pv[m][bj] = *(const v4u*)(PP + (size_t)(row0 + ai * HALF + m * 16) * D + col0 + bj * HALF);
#pragma unroll
            for (int m = 0; m < 4; ++m)
#pragma unroll
                for (int bj = 0; bj < 2; ++bj) { f32x4 p0, p1; unpack4x2(pv[m][bj], p0, p1); const f32x4 g0 = acc[ai][bj][m][0] + bv[bj][0], g1 = acc[ai][bj][m][1] + bv[bj][1]; f32x4 o0, o1;
#pragma unroll
                    for (int j = 0; j < 4; ++j) { o0[j] = __builtin_amdgcn_rcpf(1.f + __expf(-g0[j])) * p0[j]; o1[j] = __builtin_amdgcn_rcpf(1.f + __expf(-g1[j])) * p1[j]; }
                    *(u32x4*)(PP + (size_t)(row0 + ai * HALF + m * 16) * D + col0 + bj * HALF) = pack8(o0, o1); }
        }
    }
};
struct EpiDown {
    static constexpr bool PERM = true, AFTER_DRAIN = false;
    bf16* YS; const float* lw; const int* list;
    __device__ __forceinline__ void operator()(EPI_ARGS) const {
        const int col0 = u.pn * BM + wc * 32 + 8 * fq;
#pragma unroll
        for (int ai = 0; ai < 2; ++ai)
#pragma unroll
            for (int m = 0; m < 4; ++m) { const int r = ai * HALF + wr * 64 + m * 16 + fr, rank = u.r0 + r;
                if (rank < u.ce) { const float w = lw[(size_t)u.e * LCAP + rank]; const int dst = list[(size_t)u.e * LCAP + rank];
                    bf16* rowp = YS + (size_t)dst * D + col0;
#pragma unroll
                    for (int bj = 0; bj < 2; ++bj) *(u32x4*)(rowp + bj * HALF) = pack8(acc[ai][bj][m][0] * w, acc[ai][bj][m][1] * w); } }
    }
};

struct EpiRes {
    static constexpr bool PERM = true, AFTER_DRAIN = false;
    const bf16* xin; bf16* Y;
    __device__ __forceinline__ void operator()(EPI_ARGS) const {
        const int row0 = u.pm * BM + wr * 64 + fr, col0 = u.pn * BM + wc * 32 + 8 * fq;
#pragma unroll
        for (int ai = 0; ai < 2; ++ai) {
            v4u xv[4][2];
#pragma unroll
            for (int m = 0; m < 4; ++m)
#pragma unroll
                for (int bj = 0; bj < 2; ++bj) xv[m][bj] = *(const v4u*)(xin + (size_t)(row0 + ai * HALF + m * 16) * D + col0 + bj * HALF);
#pragma unroll
            for (int m = 0; m < 4; ++m)
#pragma unroll
                for (int bj = 0; bj < 2; ++bj) { f32x4 lo, hi; unpack4x2(xv[m][bj], lo, hi);
                    *(u32x4*)(Y + (size_t)(row0 + ai * HALF + m * 16) * D + col0 + bj * HALF) = pack8(ALPHA * lo + acc[ai][bj][m][0], ALPHA * hi + acc[ai][bj][m][1]); }
        }
    }
};

template <class Epi, class Sched>
__device__ __forceinline__ void gemm_phase(LAS unsigned char* lds, const int K, const Sched& S, const Epi& E) {
    int tid = threadIdx.x; asm volatile("" : "+v"(tid));
    const int wid = __builtin_amdgcn_readfirstlane(tid >> 6), lane = tid & 63, wr = wid >> 2, wc = wid & 3, fr = lane & 15, fq = lane >> 4;
    const int nt = K / BK;
    unsigned voffA[2], voffB[2];
#pragma unroll
    for (int i = 0; i < 2; ++i) { int R, C; stage_rc(tid * 16 + i * 8192, R, C); const int Rb = Epi::PERM ? ((R & ~31) + perm32(R & 31)) : R; voffA[i] = (unsigned)(R * K + C) * 2u; voffB[i] = (unsigned)(Rb * K + C) * 2u; }
    asm volatile("" : "+v"(voffA[0]), "+v"(voffA[1]), "+v"(voffB[0]), "+v"(voffB[1]));
    const size_t kstep = (size_t)(BK * 2);
    const size_t hstep = (size_t)HALF * K * 2;
    const unsigned ldsw = (unsigned)wid * 1024u;
    const int aoff = lds_byte(wr * 64 + fr, fq * 8), boff = lds_byte(wc * 32 + fr, fq * 8);
#define PG8_SA(b, h) (((b) * 2 + (h)) * HTB)
#define PG8_SB(b, h) ((4 + (b) * 2 + (h)) * HTB)
#define PG8_STAGE_B(bufoff, gbase) do { _Pragma("unroll") for (int _i = 0; _i < 2; ++_i) \
        __builtin_amdgcn_global_load_lds((const unsigned*)((const char*)(gbase) + voffB[_i]), (LAS unsigned*)(lds + (bufoff) + ldsw + _i * 8192), 16, 0, 0); } while (0)
#define PG8_STAGE_A(bufoff, gbase, VO, h) do { _Pragma("unroll") for (int _i = 0; _i < 2; ++_i) { \
        if constexpr (Sched::GATHER) __builtin_amdgcn_global_load_lds((const unsigned*)((const char*)(gbase) + (VO)[h][_i]), (LAS unsigned*)(lds + (bufoff) + ldsw + _i * 8192), 16, 0, 0); \
        else __builtin_amdgcn_global_load_lds((const unsigned*)((const char*)(gbase) + (h) * hstep + voffA[_i]), (LAS unsigned*)(lds + (bufoff) + ldsw + _i * 8192), 16, 0, 0); } } while (0)
#define PG8_LDA(dst, b, h) do { _Pragma("unroll") for (int m = 0; m < 4; ++m) _Pragma("unroll") for (int k = 0; k < 2; ++k) dst[m][k] = *(const LAS bf16x8*)(lds + PG8_SA(b, h) + aoff + m * 2048 + k * 1024); } while (0)
#define PG8_LDB(dst, b, h) do { _Pragma("unroll") for (int n = 0; n < 2; ++n) _Pragma("unroll") for (int k = 0; k < 2; ++k) dst[n][k] = *(const LAS bf16x8*)(lds + PG8_SB(b, h) + boff + n * 2048 + k * 1024); } while (0)
#define PG8_MMA(ai, bj, At, Bt) do { __builtin_amdgcn_s_setprio(1); _Pragma("unroll") for (int m = 0; m < 4; ++m) _Pragma("unroll") for (int n = 0; n < 2; ++n) _Pragma("unroll") for (int k = 0; k < 2; ++k) \
        acc[ai][bj][m][n] = __builtin_amdgcn_mfma_f32_16x16x32_bf16(Bt[n][k], At[m][k], acc[ai][bj][m][n], 0, 0, 0); __builtin_amdgcn_s_setprio(0); } while (0)
#define PG8_WAIT_V(n) asm volatile("s_waitcnt vmcnt(" #n ")" ::: "memory")
#define PG8_WAIT_L(n) asm volatile("s_waitcnt lgkmcnt(" #n ")" ::: "memory")
#define PG8_BAR __builtin_amdgcn_s_barrier()
#define PG8_SCHED __builtin_amdgcn_sched_barrier(0)
    Unit cur, nxt; int ui = 0;
    if (!S.next(0, cur)) return;
    f32x4 acc[2][2][4][2];
#pragma unroll
    for (int a = 0; a < 2; ++a)
#pragma unroll
        for (int b = 0; b < 2; ++b)
#pragma unroll
            for (int m = 0; m < 4; ++m)
#pragma unroll
                for (int n = 0; n < 2; ++n) acc[a][b][m][n] = (f32x4){0.f, 0.f, 0.f, 0.f};
    bf16x8 At[4][2], B0[2][2], B1[2][2];
    unsigned vA[2][2], vN[2][2];
    S.a_offs(cur, vA, tid);
    const char* cA = S.a_base(cur); const char* cB = S.b_base(cur);
    PG8_STAGE_B(PG8_SB(0, 0), cB); PG8_STAGE_B(PG8_SB(0, 1), cB + hstep); PG8_STAGE_A(PG8_SA(0, 0), cA, vA, 0); PG8_STAGE_A(PG8_SA(0, 1), cA, vA, 1);
    if (wr == 1) PG8_BAR;
    PG8_WAIT_V(2); PG8_BAR;
    PG8_STAGE_B(PG8_SB(1, 0), cB + kstep); PG8_STAGE_A(PG8_SA(1, 0), cA + kstep, vA, 0); PG8_STAGE_B(PG8_SB(1, 1), cB + hstep + kstep);
    PG8_WAIT_V(6); PG8_BAR;
    for (;;) {
        const bool has_next = S.next(ui + 1, nxt);
        const char* nA = has_next ? S.a_base(nxt) : cA; const char* nB = has_next ? S.b_base(nxt) : cB;
        if constexpr (Sched::GATHER) { if (has_next) S.a_offs(nxt, vN, tid); else {
#pragma unroll
            for (int h = 0; h < 2; ++h)
#pragma unroll
                for (int i = 0; i < 2; ++i) vN[h][i] = vA[h][i]; } }
#pragma nounroll
        for (int t = 0; t < nt; t += 2) {
            const bool last = (t == nt - 2);
            const char* a1 = cA + (size_t)(t + 1) * kstep;
            const char* a2 = last ? nA : cA + (size_t)(t + 2) * kstep; const char* b2 = last ? nB : cB + (size_t)(t + 2) * kstep;
            const char* a3 = a2 + kstep; const char* b3 = b2 + kstep;
            PG8_LDB(B0, 0, 0); PG8_LDB(B1, 0, 1); PG8_SCHED; PG8_LDA(At, 0, 0); PG8_STAGE_A(PG8_SA(1, 1), a1, vA, 1);
            if constexpr (Sched::GATHER) { if (last) {
#pragma unroll
                for (int h = 0; h < 2; ++h)
#pragma unroll
                    for (int i = 0; i < 2; ++i) vA[h][i] = vN[h][i]; } }
            PG8_WAIT_V(8); PG8_WAIT_L(0); PG8_BAR; PG8_MMA(0, 0, At, B0); PG8_MMA(0, 1, At, B1); PG8_BAR; PG8_SCHED;
            PG8_LDA(At, 0, 1); PG8_STAGE_B(PG8_SB(0, 0), b2); PG8_STAGE_B(PG8_SB(0, 1), b2 + hstep); PG8_STAGE_A(PG8_SA(0, 0), a2, vA, 0);
            PG8_WAIT_V(8); PG8_WAIT_L(0); PG8_BAR; PG8_MMA(1, 0, At, B0); PG8_MMA(1, 1, At, B1); PG8_BAR; PG8_SCHED;
            PG8_LDB(B0, 1, 0); PG8_LDB(B1, 1, 1); PG8_SCHED; PG8_LDA(At, 1, 0); PG8_STAGE_A(PG8_SA(0, 1), a2, vA, 1);
            PG8_WAIT_V(8); PG8_WAIT_L(0); PG8_BAR; PG8_MMA(0, 0, At, B0); PG8_MMA(0, 1, At, B1); PG8_BAR; PG8_SCHED;
            PG8_LDA(At, 1, 1); PG8_STAGE_B(PG8_SB(1, 0), b3); PG8_STAGE_B(PG8_SB(1, 1), b3 + hstep); PG8_STAGE_A(PG8_SA(1, 0), a3, vA, 0);
            PG8_WAIT_V(8); PG8_WAIT_L(0); PG8_BAR; PG8_MMA(1, 0, At, B0); PG8_MMA(1, 1, At, B1); PG8_BAR; PG8_SCHED;
        }
        if (wr == 0) PG8_BAR;
        if constexpr (!Epi::AFTER_DRAIN) { E(acc, cur, wr, wc, fr, fq); }
        if (!has_next) break;
#pragma unroll
        for (int a = 0; a < 2; ++a)
#pragma unroll
            for (int b = 0; b < 2; ++b)
#pragma unroll
                for (int m = 0; m < 4; ++m)
#pragma unroll
                    for (int n = 0; n < 2; ++n) acc[a][b][m][n] = (f32x4){0.f, 0.f, 0.f, 0.f};
        cur = nxt; cA = nA; cB = nB; ++ui;
        if (wr == 1) PG8_BAR;
    }
    PG8_WAIT_V(0);
    PG8_BAR;
#undef PG8_SA
#undef PG8_SB
#undef PG8_STAGE_A
#undef PG8_STAGE_B
#undef PG8_LDA
#undef PG8_LDB
#undef PG8_MMA
#undef PG8_WAIT_V
#undef PG8_WAIT_L
#undef PG8_BAR
#undef PG8_SCHED
}
}
constexpr int NWAVES = 8;
constexpr int RING_BYTES = 131072, EXT_OFF = 139264, LDS_BYTES = 155648;
constexpr int EXT_MISC = 0, EXT_TB = 256, EXT_CT = 512, EXT_T2E = 768;
constexpr size_t WS_X = 1 * MiB;
constexpr int CW_TMO = 0, CW_CODE = 1, CW_BAR = 4096, CW_SEAM = 16384, SEAM_BANK = 64 * 64;
constexpr int N_PHASES = 17;

#define GAS __attribute__((address_space(1)))
typedef GAS unsigned gu32;
#define RLX_AGENT __ATOMIC_RELAXED, __HIP_MEMORY_SCOPE_AGENT
#define VM_WAIT() asm volatile("s_waitcnt vmcnt(0)" ::: "memory")

#define XB_TMO      128
#define XB_XCNT(j)  (256  + 64 * (j))
#define XB_XSUB(j)  (1280 + 64 * (j))
#define XB_XGEN(j)  (2304 + 64 * (j))
#define XB_TOP      3328
#define XB_TOPGEN   3392
#define XCD_BAR_WORDS 3456
#define XB_SPIN_CAP (1u << 18)
__device__ __forceinline__ unsigned xb_ld(unsigned* p)              { return __hip_atomic_load(p, __ATOMIC_RELAXED, __HIP_MEMORY_SCOPE_AGENT); }
__device__ __forceinline__ unsigned xb_add(unsigned* p, unsigned v) { return __hip_atomic_fetch_add(p, v, __ATOMIC_RELAXED, __HIP_MEMORY_SCOPE_AGENT); }
__device__ __forceinline__ unsigned xb_xcc_id() { return (unsigned)__builtin_amdgcn_s_getreg((3 << 11) | 20) & 0xFu; }
#define XB_SPIN(cond, bar) do { unsigned _sp = 0; while (cond) { __builtin_amdgcn_s_sleep(1); \
    if ((++_sp & 255u) == 0u) { if (xb_ld(&(bar)[XB_TMO])) break; if (_sp > XB_SPIN_CAP) { atomicAdd(&(bar)[XB_TMO], 1u); break; } } } } while (0)
struct XcdBarrier { unsigned* bar; unsigned x; volatile LAS unsigned* st; };
__device__ __forceinline__ XcdBarrier xcd_barrier_post(unsigned* bar, volatile LAS unsigned* st) {
    XcdBarrier b; b.bar = bar; b.x = xb_xcc_id(); b.st = st;
    if (threadIdx.x == 0) (void)xb_add(&bar[XB_XCNT(b.x)], 1u);
    return b;
}
__device__ __forceinline__ void xcd_barrier_complete(unsigned* bar, unsigned x, unsigned& nloc, unsigned& nx) {
    const unsigned G = gridDim.x * gridDim.y * gridDim.z;
    unsigned sum, cnt, mine, sp = 0u;
    for (;;) {
        sum = 0u; cnt = 0u; mine = 0u;
#pragma unroll
        for (unsigned j = 0; j < 16; ++j) { const unsigned c = xb_ld(&bar[XB_XCNT(j)]); sum += c; cnt += (c > 0u) ? 1u : 0u; mine = (j == x) ? c : mine; }
        if (sum == G) break;
        __builtin_amdgcn_s_sleep(1);
        if ((++sp & 255u) == 0u) { if (xb_ld(&bar[XB_TMO])) break; if (sp > XB_SPIN_CAP) { atomicAdd(&bar[XB_TMO], 1u); break; } }
    }
    nloc = mine > 0u ? mine : 1u; nx = cnt > 0u ? cnt : 1u;
}
__device__ __forceinline__ void xcd_barrier(const XcdBarrier& b) {
    asm volatile("s_waitcnt vmcnt(0)" ::: "memory");
    __syncthreads();
    if (threadIdx.x == 0) {
        unsigned* bar = b.bar;
        __builtin_amdgcn_s_waitcnt(0);
        unsigned nloc = b.st[0], nx = b.st[1];
        if (nloc == 0u) { xcd_barrier_complete(bar, b.x, nloc, nx); b.st[0] = nloc; b.st[1] = nx; }
        const unsigned old = xb_add(&bar[XB_XSUB(b.x)], 1u);
        const unsigned gen = old / nloc;
        if (old + 1u == (gen + 1u) * nloc) {
            __builtin_amdgcn_fence(__ATOMIC_RELEASE, "agent");
            asm volatile("s_waitcnt vmcnt(0)" ::: "memory");
            const unsigned og = xb_add(&bar[XB_TOP], 1u);
            const unsigned tg = og / nx;
            if (og + 1u == (tg + 1u) * nx) xb_add(&bar[XB_TOPGEN], 1u);
            else XB_SPIN(xb_ld(&bar[XB_TOPGEN]) == tg, bar);
            __builtin_amdgcn_fence(__ATOMIC_ACQUIRE, "agent");
            xb_add(&bar[XB_XGEN(b.x)], 1u);
            asm volatile("s_waitcnt vmcnt(0)" ::: "memory");
        } else {
            XB_SPIN(xb_ld(&bar[XB_XGEN(b.x)]) == gen, bar);
            __builtin_amdgcn_fence(__ATOMIC_ACQUIRE, "agent");
            asm volatile("s_waitcnt vmcnt(0)" ::: "memory");
        }
    }
    __syncthreads();
}

__device__ __forceinline__ int moe_tables(const unsigned* cnt, LAS unsigned char* ext, int tid) {
    LAS int* tb = (LAS int*)(ext + EXT_TB); LAS int* ct = (LAS int*)(ext + EXT_CT); LAS int* t2e = (LAS int*)(ext + EXT_T2E);
    __syncthreads();
    if (tid < NEXP) ct[tid] = (int)__hip_atomic_load(cnt + tid, RLX_AGENT);
    __syncthreads();
    if (tid == 0) { int t = 0; for (int e = 0; e < NEXP; ++e) { tb[e] = t; t += (ct[e] + 255) >> 8; } tb[NEXP] = t; }
    __syncthreads();
    const int T = tb[NEXP];
    for (int mt = tid; mt < T; mt += NWAVES * 64) { int e = 0; while (e < NEXP - 1 && mt >= tb[e + 1]) ++e; t2e[mt] = e; }
    __syncthreads();
    return 4 * T;
}

__device__ __forceinline__ void unpack8(const v4u x, float (&f)[8]) {
    f[0] = __uint_as_float(x.x << 16); f[1] = __uint_as_float(x.x & 0xffff0000u); f[2] = __uint_as_float(x.y << 16); f[3] = __uint_as_float(x.y & 0xffff0000u);
    f[4] = __uint_as_float(x.z << 16); f[5] = __uint_as_float(x.z & 0xffff0000u); f[6] = __uint_as_float(x.w << 16); f[7] = __uint_as_float(x.w & 0xffff0000u); }
__device__ __forceinline__ void phase_mixer(const Params& p, int l, LAS unsigned char* lds, int vcu, int G, int wave, int lane) {
    constexpr int RU = 64, PITCH = 1040;
    const bf16* Z = (const bf16*)(p.ws + WS_Z); bf16* A2 = (bf16*)(p.ws + WS_A2);
    const float* cw = p.in[I_CONVW] + (size_t)l * 3 * 512; const float* ps = p.in[I_PSCALE] + (size_t)l * 512;
    const bf16* PW = (const bf16*)(p.ws + WS_SMALLW + (size_t)l * SW_LAYER + SW_PW);
    const int c8 = 8 * lane, fr = lane & 15, fq = lane >> 4;
    float w0[8], w1[8], w2[8];
#pragma unroll
    for (int j = 0; j < 8; ++j) { w0[j] = cw[c8 + j]; w1[j] = cw[512 + c8 + j]; w2[j] = cw[1024 + c8 + j]; }
    const int pg = lane >> 4, PWIN = 2 << pg, left = PWIN >> 1, right = PWIN - 1 - left;
    const int g2 = wave >> 1, dh = wave & 1;
    bf16x8 Bf[4][4];
#pragma unroll
    for (int nb = 0; nb < 4; ++nb)
#pragma unroll
        for (int ks = 0; ks < 4; ++ks) { const int d = 64 * dh + 16 * (fr >> 2) + 4 * nb + (fr & 3); Bf[nb][ks] = *(const bf16x8*)(PW + ((size_t)g2 * 128 + d) * 128 + 32 * ks + 8 * fq); }
    float sc[16];
#pragma unroll
    for (int q = 0; q < 16; ++q) sc[q] = ps[128 * g2 + 64 * dh + 16 * fq + q];
    for (int unit = vcu; unit < NTOK / RU; unit += G) {
        const int t0 = unit * RU, tw = t0 + 8 * wave;
        {
            const int tt0 = tw & (SEQ - 1);
            v4u vm = (v4u){0u, 0u, 0u, 0u}; if (tt0 > 0) vm = *(const v4u*)(Z + (size_t)(tw - 1) * DZ + c8);
            v4u v0 = *(const v4u*)(Z + (size_t)tw * DZ + c8);
#pragma unroll
            for (int r = 0; r < 8; ++r) { const int t = tw + r, tt = t & (SEQ - 1);
                v4u vp = (v4u){0u, 0u, 0u, 0u}; if (tt < SEQ - 1) vp = *(const v4u*)(Z + (size_t)(t + 1) * DZ + c8);
                const v4u gb = *(const v4u*)(Z + (size_t)t * DZ + 512 + c8);
                float a[8], b[8], c[8], g[8], o[8]; unpack8(vm, a); unpack8(v0, b); unpack8(vp, c); unpack8(gb, g);
#pragma unroll
                for (int j = 0; j < 8; ++j) o[j] = g[j] * (w0[j] * a[j] + w1[j] * b[j] + w2[j] * c[j]);
                v4u ov; ov.x = pk2(o[0], o[1]); ov.y = pk2(o[2], o[3]); ov.z = pk2(o[4], o[5]); ov.w = pk2(o[6], o[7]);
                *(v4u*)(A2 + (size_t)t * D + c8) = ov; vm = v0; v0 = vp; }
        }
        {
            const bf16* U = Z + 1024 + c8; const int tt0 = tw & (SEQ - 1); const size_t seq0 = (size_t)(tw - tt0);
            float S[8];
#pragma unroll
            for (int j = 0; j < 8; ++j) S[j] = 0.f;
            for (int q = 0; q < 16; ++q) { const int tq = tt0 - left + q; if (q < PWIN && tq >= 0 && tq < SEQ) { float f[8]; unpack8(*(const v4u*)(U + (seq0 + tq) * DZ), f);
#pragma unroll
                    for (int j = 0; j < 8; ++j) S[j] += f[j]; } }
#pragma unroll
            for (int r = 0; r < 8; ++r) { const int tt = tt0 + r;
                if (r > 0) { const int tin = tt + right, tout = tt - 1 - left;
                    if (tin < SEQ) { float f[8]; unpack8(*(const v4u*)(U + (seq0 + tin) * DZ), f);
#pragma unroll
                        for (int j = 0; j < 8; ++j) S[j] += f[j]; }
                    if (tout >= 0) { float f[8]; unpack8(*(const v4u*)(U + (seq0 + tout) * DZ), f);
#pragma unroll
                        for (int j = 0; j < 8; ++j) S[j] -= f[j]; } }
                const int lo = tt - left < 0 ? 0 : tt - left, hi = tt + right > SEQ - 1 ? SEQ - 1 : tt + right; const float inv = 1.f / (float)(hi - lo + 1);
                float f[8], o[8]; unpack8(*(const v4u*)(U + (seq0 + tt) * DZ), f);
#pragma unroll
                for (int j = 0; j < 8; ++j) o[j] = S[j] * inv - f[j];
                v4u ov; ov.x = pk2(o[0], o[1]); ov.y = pk2(o[2], o[3]); ov.z = pk2(o[4], o[5]); ov.w = pk2(o[6], o[7]);
                *(LAS v4u*)(lds + (8 * wave + r) * PITCH + 16 * lane) = ov; }
        }
        __syncthreads();
#pragma unroll
        for (int mb = 0; mb < 4; ++mb) {
            f32x4 acc[4];
#pragma unroll
            for (int nb = 0; nb < 4; ++nb) acc[nb] = (f32x4){0.f, 0.f, 0.f, 0.f};
#pragma unroll
            for (int ks = 0; ks < 4; ++ks) { const bf16x8 Af = *(const LAS bf16x8*)(lds + (16 * mb + fr) * PITCH + 2 * (128 * g2 + 32 * ks + 8 * fq));
#pragma unroll
                for (int nb = 0; nb < 4; ++nb) acc[nb] = __builtin_amdgcn_mfma_f32_16x16x32_bf16(Bf[nb][ks], Af, acc[nb], 0, 0, 0); }
            bf16* op = A2 + (size_t)(t0 + 16 * mb + fr) * D + 512 + 128 * g2 + 64 * dh + 16 * fq;
            v4u o0, o1;
            o0.x = pk2(acc[0][0] * sc[0], acc[0][1] * sc[1]); o0.y = pk2(acc[0][2] * sc[2], acc[0][3] * sc[3]); o0.z = pk2(acc[1][0] * sc[4], acc[1][1] * sc[5]); o0.w = pk2(acc[1][2] * sc[6], acc[1][3] * sc[7]);
            o1.x = pk2(acc[2][0] * sc[8], acc[2][1] * sc[9]); o1.y = pk2(acc[2][2] * sc[10], acc[2][3] * sc[11]); o1.z = pk2(acc[3][0] * sc[12], acc[3][1] * sc[13]); o1.w = pk2(acc[3][2] * sc[14], acc[3][3] * sc[15]);
            *(v4u*)op = o0; *(v4u*)(op + 8) = o1;
        }
        __syncthreads();
    }
}


constexpr int RT_B = 0, RT_BPITCH = 1040, RT_GB = 99840, RT_LG = 108032, RT_EX = 134656, RT_WT = 135680, RT_LR = 136704, RT_HIST = 137728, RT_CH = 138240, RT_PART = 99840;
static_assert(RT_LG + 8 * 16 * 52 * 4 <= RT_EX && RT_CH + 512 <= 139264, "routing LDS map");
__device__ __forceinline__ void phase_route(const Params& p, int l, LAS unsigned char* lds, int bx, int wave, int lane, int tid, size_t dofs) {
    bf16* X = (bf16*)(p.ws + WS_XH1);
    const bf16* WR = (const bf16*)(p.ws + WS_SMALLW + (size_t)l * SW_LAYER + SW_WR);
    const int fr = lane & 15, fq = lane >> 4, tok0 = 128 * bx + 16 * wave;
    bf16x8 af[32];
    bf16* xrow = X + (size_t)(tok0 + fr) * D + 8 * fq;
#pragma unroll
    for (int ks = 0; ks < 32; ++ks) af[ks] = *(const bf16x8*)(xrow + 32 * ks);
    { LAS float* GB = (LAS float*)(lds + RT_GB); const float* g = p.in[I_LN1G] + (size_t)l * D; const float* b = p.in[I_LN1B] + (size_t)l * D;
      for (int i = tid; i < 2 * D; i += NWAVES * 64) GB[i] = i < D ? g[i] : b[i - D]; }
#define RT_STAGE_B(half) do { for (int c = tid; c < 96 * 64; c += NWAVES * 64) { const int row = c >> 6, cc = c & 63; \
        *(LAS v4u*)(lds + RT_B + row * RT_BPITCH + 16 * cc) = *(const v4u*)(WR + (size_t)row * D + 512 * (half) + 8 * cc); } } while (0)
    RT_STAGE_B(0);
    float s = 0.f;
#pragma unroll
    for (int ks = 0; ks < 32; ++ks) { f32x4 lo, hi; pg8::unpack4x2(__builtin_bit_cast(v4u, af[ks]), lo, hi); s += ((lo[0] + lo[1]) + (lo[2] + lo[3])) + ((hi[0] + hi[1]) + (hi[2] + hi[3])); }
    s += __shfl_xor(s, 16); s += __shfl_xor(s, 32);
#define RT_PIN() do { _Pragma("unroll") for (int _k = 0; _k < 32; ++_k) asm volatile("" : "+v"(af[_k])); } while (0)
    RT_PIN();
    const float mean = s * (1.f / D); float q = 0.f;
#pragma unroll
    for (int ks = 0; ks < 32; ++ks) { f32x4 lo, hi; pg8::unpack4x2(__builtin_bit_cast(v4u, af[ks]), lo, hi); lo = lo - mean; hi = hi - mean;
        q += ((lo[0] * lo[0] + lo[1] * lo[1]) + (lo[2] * lo[2] + lo[3] * lo[3])) + ((hi[0] * hi[0] + hi[1] * hi[1]) + (hi[2] * hi[2] + hi[3] * hi[3])); }
    q += __shfl_xor(q, 16); q += __shfl_xor(q, 32);
    const float rstd = 1.f / sqrtf(q * (1.f / D) + LN_EPS);
    RT_PIN();
    __syncthreads();
    { const LAS float* GB = (const LAS float*)(lds + RT_GB);
#pragma unroll
      for (int ks = 0; ks < 32; ++ks) { f32x4 lo, hi; pg8::unpack4x2(__builtin_bit_cast(v4u, af[ks]), lo, hi); const int k = 32 * ks + 8 * fq;
          const f32x4 g0 = *(const LAS f32x4*)(GB + k), g1 = *(const LAS f32x4*)(GB + k + 4), b0 = *(const LAS f32x4*)(GB + D + k), b1 = *(const LAS f32x4*)(GB + D + k + 4);
          const pg8::u32x4 w = pg8::pack8((lo - mean) * rstd * g0 + b0, (hi - mean) * rstd * g1 + b1);
          af[ks] = __builtin_bit_cast(bf16x8, w); *(pg8::u32x4*)(xrow + 32 * ks) = w; } }
    f32x4 acc[3];
#pragma unroll
    for (int nb = 0; nb < 3; ++nb) acc[nb] = (f32x4){0.f, 0.f, 0.f, 0.f};
#define RT_MMA(half) do { _Pragma("unroll") for (int k2 = 0; k2 < 16; ++k2) { _Pragma("unroll") for (int nb = 0; nb < 3; ++nb) { \
        const bf16x8 Bh = *(const LAS bf16x8*)(lds + RT_B + (16 * nb + fr) * RT_BPITCH + 2 * (32 * k2 + 8 * fq)), Bl = *(const LAS bf16x8*)(lds + RT_B + (48 + 16 * nb + fr) * RT_BPITCH + 2 * (32 * k2 + 8 * fq)); \
        acc[nb] = __builtin_amdgcn_mfma_f32_16x16x32_bf16(Bh, af[16 * (half) + k2], acc[nb], 0, 0, 0); acc[nb] = __builtin_amdgcn_mfma_f32_16x16x32_bf16(Bl, af[16 * (half) + k2], acc[nb], 0, 0, 0); } } } while (0)
    RT_MMA(0);
    __syncthreads();
    RT_STAGE_B(1);
    __syncthreads();
    RT_MMA(1);
#undef RT_STAGE_B
#undef RT_MMA
    LAS float* Lg = (LAS float*)(lds + RT_LG);
#pragma unroll
    for (int nb = 0; nb < 3; ++nb)
#pragma unroll
        for (int j = 0; j < 4; ++j) Lg[(16 * wave + fr) * 52 + 16 * nb + 4 * fq + j] = acc[nb][j];
    __syncthreads();
    LAS int* EX = (LAS int*)(lds + RT_EX); LAS float* WT = (LAS float*)(lds + RT_WT); LAS int* LR = (LAS int*)(lds + RT_LR); LAS int* HIST = (LAS int*)(lds + RT_HIST); LAS int* CH = (LAS int*)(lds + RT_CH);
    if (tid < 128) {
        const LAS float* r0 = Lg + tid * 52;
        float lg[4];
#pragma unroll
        for (int g = 0; g < 4; ++g) lg[g] = r0[g] + p.in[I_BRG][l * 4 + g];
        int gs = 0; float gm = lg[0];
#pragma unroll
        for (int g = 1; g < 4; ++g) if (lg[g] > gm) { gm = lg[g]; gs = g; }
        float den = 0.f;
#pragma unroll
        for (int g = 0; g < 4; ++g) den += __expf(lg[g] - gm);
        const float g_w = 1.f / den;
        float el[8];
#pragma unroll
        for (int e = 0; e < 8; ++e) el[e] = r0[4 + 8 * gs + e] + p.in[I_BRE][(l * 4 + gs) * 8 + e];
        int i0 = 0; float v0 = el[0];
#pragma unroll
        for (int e = 1; e < 8; ++e) if (el[e] > v0) { v0 = el[e]; i0 = e; }
        int i1 = -1; float v1 = -3.0e38f;
#pragma unroll
        for (int e = 0; e < 8; ++e) if (e != i0 && el[e] > v1) { v1 = el[e]; i1 = e; }
        const float ex = __expf(v1 - v0);
        EX[2 * tid] = gs * 8 + i0; EX[2 * tid + 1] = gs * 8 + i1; WT[2 * tid] = g_w / (1.f + ex); WT[2 * tid + 1] = g_w * ex / (1.f + ex);
    }
    __syncthreads();
    int my_e = 0, my_lr = 0;
    if (wave < 4) {
        my_e = EX[64 * wave + lane]; int my_cnt = 0;
        const unsigned long long below = (1ull << lane) - 1ull;
        for (int x = 0; x < NEXP; ++x) { const unsigned long long mk = __ballot(my_e == x); if (my_e == x) my_lr = __popcll(mk & below); if (lane == x) my_cnt = __popcll(mk); }
        if (lane < NEXP) CH[wave * NEXP + lane] = my_cnt;
    }
    __syncthreads();
    if (wave < 4) { int before = 0; for (int w = 0; w < wave; ++w) before += CH[w * NEXP + my_e]; LR[64 * wave + lane] = my_lr + before; }
    if (tid < NEXP) HIST[tid] = CH[tid] + CH[NEXP + tid] + CH[2 * NEXP + tid] + CH[3 * NEXP + tid];
    __syncthreads();
    if (tid < NEXP) ((int*)(p.ws + WS_HIST + dofs))[bx * NEXP + tid] = HIST[tid];
    if (tid < 128) { const int t = tid, tok = 128 * bx + t;
        int4 rc; rc.x = EX[2 * t]; rc.y = LR[2 * t]; rc.z = EX[2 * t + 1]; rc.w = LR[2 * t + 1]; ((int4*)(p.ws + WS_TOKREC + dofs))[tok] = rc;
        float2 w; w.x = WT[2 * t]; w.y = WT[2 * t + 1]; ((float2*)(p.ws + WS_TOKW + dofs))[tok] = w; }
    __syncthreads();
}
__device__ __forceinline__ void phase_scatter(const Params& p, int l, LAS unsigned char* lds, int bx, int G, int tid, size_t dofs, int cslot) {
    const int* hist = (const int*)(p.ws + WS_HIST + dofs);
    LAS int* PART = (LAS int*)(lds + RT_PART);
    LAS int* BASE = (LAS int*)(lds + RT_HIST); LAS int* TOT = BASE + 32;
    { const int t = tid, e = t & 31, part = t >> 5; int sb = 0, sa = 0;
      for (int w = part * 16; w < part * 16 + 16; ++w) { const int h = w < G ? hist[w * NEXP + e] : 0; sa += h; if (w < bx) sb += h; }
      PART[part * 32 + e] = sb; PART[512 + part * 32 + e] = sa; }
    __syncthreads();
    if (tid < NEXP) { int sb = 0, sa = 0; for (int q = 0; q < 16; ++q) { sb += PART[q * 32 + tid]; sa += PART[512 + q * 32 + tid]; } BASE[tid] = sb; TOT[tid] = sa;
        if (bx == 0) ((unsigned*)(p.ws + WS_CTL))[CW_CNT + 64 * cslot + tid] = (unsigned)sa; }
    __syncthreads();
    if (tid < 128) { const int tok = 128 * bx + tid;
        int4 rc = ((const int4*)(p.ws + WS_TOKREC + dofs))[tok]; const float2 w = ((const float2*)(p.ws + WS_TOKW + dofs))[tok];
        rc.y += BASE[rc.x]; rc.w += BASE[rc.z];
        int* list = (int*)(p.ws + WS_LIST + dofs); float* lw = (float*)(p.ws + WS_LW + dofs);
        list[(size_t)rc.x * LCAP + rc.y] = 2 * tok; lw[(size_t)rc.x * LCAP + rc.y] = w.x;
        list[(size_t)rc.z * LCAP + rc.w] = 2 * tok + 1; lw[(size_t)rc.z * LCAP + rc.w] = w.y;
        ((int4*)(p.ws + WS_TOKREC + dofs))[tok] = rc; }
    __syncthreads();
}


__device__ __forceinline__ void phase_ln2(const Params& p, int l, int gw, int NGW, int lane) {
    const bf16* X1 = (const bf16*)(p.ws + WS_XH1); const bf16* PL = (const bf16*)(p.ws + WS_PP); const bf16* YS = (const bf16*)(p.ws + WS_YS); bf16* XO = (bf16*)(p.ws + WS_XH0);
    const float* g = p.in[I_LN2G] + (size_t)l * D; const float* b = p.in[I_LN2B] + (size_t)l * D;
    f32x4 gg[2][2], bb[2][2];
#pragma unroll
    for (int h = 0; h < 2; ++h)
#pragma unroll
        for (int q = 0; q < 2; ++q) { gg[h][q] = *(const f32x4*)(g + 512 * h + 8 * lane + 4 * q); bb[h][q] = *(const f32x4*)(b + 512 * h + 8 * lane + 4 * q); }
    for (int m = 2 * gw; m < NTOK; m += 2 * NGW) {
        v4u xv[2][2], pv[2][2], y0[2][2], y1[2][2];
#pragma unroll
        for (int r = 0; r < 2; ++r)
#pragma unroll
            for (int h = 0; h < 2; ++h) { const size_t o = (size_t)(m + r) * D + 512 * h + 8 * lane;
                xv[r][h] = *(const v4u*)(X1 + o); pv[r][h] = *(const v4u*)(PL + o); y0[r][h] = *(const v4u*)(YS + 2 * (size_t)(m + r) * D + 512 * h + 8 * lane); y1[r][h] = *(const v4u*)(YS + (2 * (size_t)(m + r) + 1) * D + 512 * h + 8 * lane); }
#pragma unroll
        for (int r = 0; r < 2; ++r) {
            f32x4 v[2][2]; float s = 0.f;
#pragma unroll
            for (int h = 0; h < 2; ++h) { f32x4 x0, x1, p0, p1, a0, a1, c0, c1; pg8::unpack4x2(xv[r][h], x0, x1); pg8::unpack4x2(pv[r][h], p0, p1); pg8::unpack4x2(y0[r][h], a0, a1); pg8::unpack4x2(y1[r][h], c0, c1);
                v[h][0] = ALPHA * x0 + (a0 + c0) + p0; v[h][1] = ALPHA * x1 + (a1 + c1) + p1;
                s += (v[h][0].x + v[h][0].y) + (v[h][0].z + v[h][0].w) + (v[h][1].x + v[h][1].y) + (v[h][1].z + v[h][1].w); }
            const float mean = wave_sum(s) * (1.f / D); float s2 = 0.f;
#pragma unroll
            for (int h = 0; h < 2; ++h)
#pragma unroll
                for (int q = 0; q < 2; ++q) { v[h][q] = v[h][q] - mean; s2 += (v[h][q].x * v[h][q].x + v[h][q].y * v[h][q].y) + (v[h][q].z * v[h][q].z + v[h][q].w * v[h][q].w); }
            const float rstd = 1.f / sqrtf(wave_sum(s2) * (1.f / D) + LN_EPS);
#pragma unroll
            for (int h = 0; h < 2; ++h) { const f32x4 o0 = v[h][0] * rstd * gg[h][0] + bb[h][0], o1 = v[h][1] * rstd * gg[h][1] + bb[h][1]; const size_t o = (size_t)(m + r) * D + 512 * h + 8 * lane;
                if (l == 1) { *(f32x4*)(p.out + o) = o0; *(f32x4*)(p.out + o + 4) = o1; }
                else { v4u w; w.x = pk2(o0.x, o0.y); w.y = pk2(o0.z, o0.w); w.z = pk2(o1.x, o1.y); w.w = pk2(o1.z, o1.w); *(v4u*)(XO + o) = w; } }
        }
    }
}

__global__ void __launch_bounds__(NWAVES * 64, 2) mk_fwd(Params p) {
    extern __shared__ __attribute__((aligned(16))) unsigned char lds_raw[];
    LAS unsigned char* lds = (LAS unsigned char*)lds_raw;
    LAS unsigned char* ext = lds + EXT_OFF;
    const int tid = threadIdx.x, wave = __builtin_amdgcn_readfirstlane(tid >> 6); int lane = tid & 63;
int ftid = tid;
#define FRESH_LANE() do { asm volatile("" : "+v"(lane)); ftid = tid; asm volatile("" : "+v"(ftid)); } while (0)
    const int G = gridDim.x, bx = blockIdx.x, vcu = (G % 8 == 0) ? (bx % 8) * (G / 8) + bx / 8 : bx;
    const int gw = bx * NWAVES + wave, NGW = G * NWAVES;
    gu32* ctl = (gu32*)(p.ws + WS_CTL);
    for (int u = tid; u < (LDS_BYTES - EXT_OFF) / 4; u += NWAVES * 64) ((LAS unsigned*)ext)[u] = 0u;
    __syncthreads();
    const int lo = p.ph_lo, hi = p.ph_hi;
    XcdBarrier bar; bar.bar = (unsigned*)ctl + CW_BAR; bar.x = 0; bar.st = nullptr;
    if (hi - lo > 1) bar = xcd_barrier_post((unsigned*)ctl + CW_BAR, (volatile LAS unsigned*)(ext + EXT_MISC) + 8);
#ifndef MK_ONLY
#define MK_ONLY -1
#endif
#define PH_ON(j) (MK_ONLY < 0 || MK_ONLY == (j))
#define IN(k) (lo <= (k) && (k) < hi)
#define SEAM(k) do { if (IN(k) && IN((k) + 1)) xcd_barrier(bar); } while (0)
    bf16* XH0 = (bf16*)(p.ws + WS_XH0); bf16* XH1 = (bf16*)(p.ws + WS_XH1);

    if (PH_ON(0) && IN(0)) {
        FRESH_LANE();
        LAS float* scr = (LAS float*)(lds + wave * TSCR_BYTES);
        phase_cvt_small(p, scr, gw, NGW, lane);
        phase_cvt_moe(p, 0, scr, gw, NGW, lane);
        phase_ln0_p(p, gw, NGW, lane);
    }
    SEAM(0);
    for (int l = 0; l < 2; ++l) {
        const int b = 1 + 8 * l;
        unsigned char* sw = p.ws + WS_SMALLW + (size_t)l * SW_LAYER;
        const unsigned* cnt = (const unsigned*)(p.ws + WS_CTL) + CW_CNT + 64 * l;
        if (PH_ON(1) && IN(b)) {
            { pg8::DenseOrder S; S.init(XH0, (const bf16*)(sw + SW_WIN), NTOK, DIN, D, G, bx);
              pg8::EpiPairZ E{(bf16*)(p.ws + WS_Z), (const float*)(sw + SW_BIN)};
              pg8::gemm_phase(lds, D, S, E); }
            { pg8::DenseOrder S; S.init((const bf16*)(p.ws + WS_PB) + (size_t)l * NTOK * DPLE, (const bf16*)(sw + SW_WP), NTOK, D, DPLE, G, bx);
              pg8::EpiPlain E{(bf16*)(p.ws + WS_PP), D};
              pg8::gemm_phase(lds, DPLE, S, E); }
        }
        SEAM(b);
        if (PH_ON(2) && IN(b + 1)) {
            FRESH_LANE();
            phase_mixer(p, l, lds, vcu, G, wave, lane);
            if (l == 1) { LAS float* scr = (LAS float*)(lds + wave * TSCR_BYTES); phase_cvt_moe(p, 1, scr, gw, NGW, lane); }
        }
        SEAM(b + 1);
        if (PH_ON(3) && IN(b + 2)) {
            pg8::DenseOrder S; S.init((const bf16*)(p.ws + WS_A2), (const bf16*)(sw + SW_WO), NTOK, D, D, G, bx);
            pg8::EpiRes E{XH0, XH1};
            pg8::gemm_phase(lds, D, S, E);
        }
        SEAM(b + 2);
        const size_t dofs = p.pad ? (WS_PO - WS_LIST) : 0;
        if (PH_ON(4) && IN(b + 3)) { FRESH_LANE(); phase_route(p, l, lds, bx, wave, lane, ftid, dofs); }
        SEAM(b + 3);
        if (PH_ON(4) && IN(b + 4)) { FRESH_LANE(); phase_scatter(p, l, lds, bx, G, ftid, dofs, l + 2 * p.pad); }
        SEAM(b + 4);
        if (PH_ON(5) && IN(b + 5)) {
            FRESH_LANE();
            const int T4 = moe_tables(cnt, ext, ftid);
            pg8::MoeOrder<true> S{(const LAS int*)(ext + EXT_TB), (const LAS int*)(ext + EXT_CT), (const LAS int*)(ext + EXT_T2E), T4, G, vcu, D, (const char*)XH1, (const char*)(p.ws + WS_WUP), (size_t)1024 * 1024 * 2, (const int*)(p.ws + WS_LIST)};
            pg8::EpiUp E{(bf16*)(p.ws + WS_H)};
            pg8::gemm_phase(lds, D, S, E);
            { const int rem = (T4 & 255), nl = 256 - rem, j = vcu - rem;
              pg8::ListOrder SG{(j >= 0) ? 1 : 0, j, -1, 512, D, (const char*)XH1, (const char*)(sw + SW_WG)};
              pg8::EpiGate EG{(bf16*)(p.ws + WS_PP), p.in[I_BG] + (size_t)l * D};
              (void)nl; pg8::gemm_phase(lds, D, SG, EG); }
        }
        SEAM(b + 5);
        if (PH_ON(6) && IN(b + 6)) {
            FRESH_LANE();
            const int T4 = moe_tables(cnt, ext, ftid);
            pg8::MoeOrder<false> S{(const LAS int*)(ext + EXT_TB), (const LAS int*)(ext + EXT_CT), (const LAS int*)(ext + EXT_T2E), T4, G, vcu, DEXP, (const char*)(p.ws + WS_H), (const char*)(p.ws + WS_WDN), (size_t)1024 * 512 * 2, (const int*)(p.ws + WS_LIST)};
            pg8::EpiDown E{(bf16*)(p.ws + WS_YS), (const float*)(p.ws + WS_LW), (const int*)(p.ws + WS_LIST)};
            pg8::gemm_phase(lds, DEXP, S, E);
            { const int rem = (T4 & 255), nl = 256 - rem, j = vcu - rem;
              pg8::ListOrder SG{(j >= 0) ? 1 : 0, nl + j, 2 * nl + vcu, 512, D, (const char*)XH1, (const char*)(sw + SW_WG)};
              pg8::EpiGate EG{(bf16*)(p.ws + WS_PP), p.in[I_BG] + (size_t)l * D};
              pg8::gemm_phase(lds, D, SG, EG); }
        }
        SEAM(b + 6);
        if (PH_ON(7) && IN(b + 7)) { FRESH_LANE(); phase_ln2(p, l, gw, NGW, lane); }
        SEAM(b + 7);
    }
#undef IN
#undef SEAM
}
#ifndef MK_FUSED
#define MK_FUSED 1
#endif
#ifndef MK_DUP
#define MK_DUP 0x0
#endif
extern "C" void kernel_launch(void* const* d_in, const int* in_sizes, int n_in, void* d_out, int out_size, void* d_ws, size_t ws_size, hipStream_t stream) {
    static int grid = 0;
    if (grid == 0) {
        if (n_in != 24 || in_sizes[0] != NTOK * D || out_size != NTOK * D || ws_size < WS_END) {
            fprintf(stderr, "kernel_launch: unexpected shapes (n_in %d, in0 %d, out %d, ws %zu < %zu); nothing launched\n", n_in, n_in > 0 ? in_sizes[0] : -1, out_size, ws_size, (size_t)WS_END); grid = -1; return; }
        int dev = 0, cus = 0, per_cu = 0;
        if (hipGetDevice(&dev) != hipSuccess || hipDeviceGetAttribute(&cus, hipDeviceAttributeMultiprocessorCount, dev) != hipSuccess) { grid = -1; return; }
        if (hipFuncSetAttribute((const void*)mk_fwd, hipFuncAttributeMaxDynamicSharedMemorySize, LDS_BYTES) != hipSuccess) { fprintf(stderr, "kernel_launch: hipFuncSetAttribute failed\n"); grid = -1; return; }
        if (hipOccupancyMaxActiveBlocksPerMultiprocessor(&per_cu, (const void*)mk_fwd, NWAVES * 64, LDS_BYTES) != hipSuccess || per_cu < 1) { fprintf(stderr, "kernel_launch: occupancy query says %d blocks per CU\n", per_cu); }
        (void)hipGetLastError();
        grid = cus;
        if (grid != 256) { fprintf(stderr, "kernel_launch: built for 256 CUs, device has %d; nothing launched\n", cus); grid = -1; return; }
    }
    if (grid < 0) return;
    (void)hipMemsetAsync((char*)d_ws + WS_CTL, 0, CTL_BYTES, stream);
    Params p{};
    for (int i = 0; i < 24; ++i) p.in[i] = (const float*)d_in[i];
    p.out = (float*)d_out; p.ws = (unsigned char*)d_ws; p.layer = 0; p.ph_lo = 0; p.ph_hi = 0; p.pad = 0;
#if MK_FUSED
    p.ph_lo = 0; p.ph_hi = N_PHASES;
    hipLaunchKernelGGL(mk_fwd, dim3(grid), dim3(NWAVES * 64), LDS_BYTES, stream, p);
#else
    for (int ph = 0; ph < N_PHASES; ++ph) {
        const int k = ph == 0 ? -1 : (ph - 1) % 8;
        p.ph_lo = ph; p.ph_hi = ph + 1; hipLaunchKernelGGL(mk_fwd, dim3(grid), dim3(NWAVES * 64), LDS_BYTES, stream, p);
        if ((MK_DUP >> ph) & 1) { if (k == 2 || k == 3 || k == 4 || k == 7) p.pad = 1; hipLaunchKernelGGL(mk_fwd, dim3(grid), dim3(NWAVES * 64), LDS_BYTES, stream, p); p.pad = 0; }
    }
#endif
}
```

```cpp
#include <hip/hip_runtime.h>
#include <stdio.h>

#define LAS __attribute__((address_space(3)))
typedef unsigned short bf16;
typedef short bf16x8 __attribute__((ext_vector_type(8)));
typedef float f32x4 __attribute__((ext_vector_type(4)));
typedef unsigned v4u __attribute__((ext_vector_type(4)));
typedef unsigned v2u __attribute__((ext_vector_type(2)));

constexpr int NTOK = 32768, SEQ = 8192, D = 1024, DZ = 1536, DIN = 2048, DPLE = 256, DEXP = 512, NEXP = 32, LCAP = 32768;
constexpr int MAXTILES = 288;
constexpr float ALPHA = 1.41421356237309515f;
constexpr float LN_EPS = 1e-5f;
constexpr float W8_SCALE = 32.f, H8_SCALE = 8.f, Y8_SCALE = 8.f;

constexpr size_t MiB = 1u << 20;
constexpr size_t WS_CTL = 0, CTL_BYTES = 1 * MiB;
constexpr size_t WS_SMALLW = 4 * MiB;
constexpr size_t SW_LAYER = 10 * MiB, SW_WIN = 0, SW_WO = 4 * MiB, SW_WG = 6 * MiB, SW_WP = 8 * MiB, SW_PW = 8 * MiB + 512 * 1024, SW_BIN = 8 * MiB + 768 * 1024, SW_WR = 9 * MiB;
constexpr size_t WS_WUP = 24 * MiB, WS_WDN = 88 * MiB;
constexpr size_t WS_XH0 = 120 * MiB, WS_XH1 = 184 * MiB;
constexpr size_t WS_PB = 248 * MiB;
constexpr size_t WS_PP = 280 * MiB;
constexpr size_t WS_LIST = 344 * MiB, WS_LW = 348 * MiB, WS_TOKREC = 352 * MiB;
constexpr size_t WS_TOKW = 352 * MiB + 512 * 1024, WS_HIST = 353 * MiB;
constexpr size_t WS_H = 354 * MiB, WS_YS = 426 * MiB;
constexpr size_t WS_A2 = WS_H, WS_Z = WS_YS;
constexpr size_t WS_XQ = 570 * MiB;
constexpr size_t WS_END = 602 * MiB;
constexpr int CW_CNT = 1024;

__device__ __forceinline__ unsigned f2bf(float f) { unsigned u = __builtin_bit_cast(unsigned, f); return (u + 0x7fffu + ((u >> 16) & 1u)) >> 16; }
__device__ __forceinline__ unsigned pk2(float lo, float hi) { return f2bf(lo) | (f2bf(hi) << 16); }
__device__ __forceinline__ float sat8(float x) { return __builtin_amdgcn_fmed3f(x, -440.f, 440.f); }
__device__ __forceinline__ unsigned pk4_fp8(float a, float b, float c, float d) { int w = 0; w = __builtin_amdgcn_cvt_pk_fp8_f32(a, b, w, false); w = __builtin_amdgcn_cvt_pk_fp8_f32(c, d, w, true); return (unsigned)w; }
typedef float f32x2_t __attribute__((ext_vector_type(2)));
__device__ __forceinline__ void unpack8_fp8(const v2u x, f32x4& lo, f32x4& hi) {
    const f32x2_t a = __builtin_amdgcn_cvt_pk_f32_fp8((int)x.x, false), b = __builtin_amdgcn_cvt_pk_f32_fp8((int)x.x, true), c = __builtin_amdgcn_cvt_pk_f32_fp8((int)x.y, false), d = __builtin_amdgcn_cvt_pk_f32_fp8((int)x.y, true);
    lo[0] = a[0]; lo[1] = a[1]; lo[2] = b[0]; lo[3] = b[1]; hi[0] = c[0]; hi[1] = c[1]; hi[2] = d[0]; hi[3] = d[1]; }
__device__ __forceinline__ float bf2f(bf16 b) { return __builtin_bit_cast(float, ((unsigned)b) << 16); }
__device__ __forceinline__ float wave_sum(float v) {
#pragma unroll
    for (int o = 1; o < 64; o <<= 1) v += __shfl_xor(v, o);
    return v;
}
#define LDS_WAIT() asm volatile("s_waitcnt lgkmcnt(0)" ::: "memory")

struct Params {
    const float* in[24];
    float* out;
    unsigned char* ws;
    int layer, ph_lo, ph_hi, pad;
};
enum { I_X = 0, I_P, I_LN0G, I_LN0B, I_WIN, I_BIN, I_CONVW, I_POOLW, I_PSCALE, I_WO, I_LN1G, I_LN1B, I_WRG, I_BRG, I_WRE, I_BRE, I_W1, I_W3, I_W2, I_WG, I_BG, I_WP, I_LN2G, I_LN2B };

constexpr int TSCR_BYTES = 64 * 65 * 4;
struct TItem { const float* src; bf16* dst; int ldw, ldt, f8; };
__device__ __forceinline__ int pair_row(int c) { return 256 * (c >> 7) + (c & 127); }
__device__ __forceinline__ void titem_load(const TItem& t, f32x4 (&v)[16], int lane) {
    const int lk = lane >> 4, ln = 4 * (lane & 15);
#pragma unroll
    for (int i = 0; i < 16; ++i) v[i] = *(const f32x4*)(t.src + (size_t)(4 * i + lk) * t.ldw + ln);
}
__device__ __forceinline__ void titem_to_lds(const f32x4 (&v)[16], LAS float* scr, int lane) {
    const int lk = lane >> 4, ln = 4 * (lane & 15);
#pragma unroll
    for (int i = 0; i < 16; ++i) { LAS float* d = scr + (4 * i + lk) * 65 + ln; d[0] = v[i].x; d[1] = v[i].y; d[2] = v[i].z; d[3] = v[i].w; }
}
__device__ __forceinline__ unsigned cvt2bf(float lo, float hi) { unsigned r; asm volatile("v_cvt_pk_bf16_f32 %0, %1, %2" : "=v"(r) : "v"(lo), "v"(hi)); return r; }
__device__ __forceinline__ void titem_finish(const TItem& t, const LAS float* scr, int lane) {
    const int c = lane & 7;
#pragma unroll
    for (int j = 0; j < 8; ++j) { const int n = (lane >> 3) + 8 * j; const LAS float* s = scr + (8 * c) * 65 + n;
        v4u o; o.x = cvt2bf(s[0 * 65], s[1 * 65]); o.y = cvt2bf(s[2 * 65], s[3 * 65]); o.z = cvt2bf(s[4 * 65], s[5 * 65]); o.w = cvt2bf(s[6 * 65], s[7 * 65]);
        *(v4u*)(t.dst + (size_t)n * t.ldt + 8 * c) = o; }
}
__device__ __forceinline__ void titem_finish8(const TItem& t, const LAS float* scr, int lane) {
    const int c = lane & 3; unsigned char* d8 = (unsigned char*)t.dst;
#pragma unroll
    for (int j = 0; j < 4; ++j) { const int n = (lane >> 2) + 16 * j; const LAS float* s = scr + (16 * c) * 65 + n; v4u o;
        o.x = pk4_fp8(s[0 * 65] * W8_SCALE, s[1 * 65] * W8_SCALE, s[2 * 65] * W8_SCALE, s[3 * 65] * W8_SCALE); o.y = pk4_fp8(s[4 * 65] * W8_SCALE, s[5 * 65] * W8_SCALE, s[6 * 65] * W8_SCALE, s[7 * 65] * W8_SCALE);
        o.z = pk4_fp8(s[8 * 65] * W8_SCALE, s[9 * 65] * W8_SCALE, s[10 * 65] * W8_SCALE, s[11 * 65] * W8_SCALE); o.w = pk4_fp8(s[12 * 65] * W8_SCALE, s[13 * 65] * W8_SCALE, s[14 * 65] * W8_SCALE, s[15 * 65] * W8_SCALE);
        *(v4u*)(d8 + (size_t)n * t.ldt + 16 * c) = o; }
}
template <class Get> __device__ __forceinline__ void cvt_loop(const Get& get, int nitems, LAS float* scr, int gw, int NGW, int lane) {
    int it = gw; if (it >= nitems) return;
    TItem cur = get(it), nxt = cur; f32x4 v[16];
    titem_load(cur, v, lane);
    for (;;) {
        titem_to_lds(v, scr, lane);
        LDS_WAIT(); asm volatile("" ::: "memory");
        const int nit = it + NGW; const bool more = nit < nitems;
        if (more) { nxt = get(nit); titem_load(nxt, v, lane); }
        if (cur.f8) titem_finish8(cur, scr, lane); else titem_finish(cur, scr, lane);
        LDS_WAIT(); asm volatile("" ::: "memory");
        if (!more) break;
        cur = nxt; it = nit;
    }
}
struct GetSmall { const Params* p;
    __device__ __forceinline__ TItem operator()(int it) const {
        constexpr int I_IN = 16 * 32, I_O = 16 * 16, I_G = 16 * 16, I_PJ = 4 * 16, I_PL = 4 * 4, PER = I_IN + I_O + I_G + I_PJ + I_PL;
        const int l = it / PER; int r = it % PER; unsigned char* sw = p->ws + WS_SMALLW + (size_t)l * SW_LAYER;
        if (r < I_IN) { const int kb = r / 32, nb = r % 32, n0 = 64 * nb; const int reg = n0 >> 9, cc = n0 & 511;
            const int drow = reg == 0 ? pair_row(cc) : reg == 1 ? 1024 + cc : reg == 2 ? pair_row(cc) + 128 : 1536 + cc;
            return TItem{p->in[I_WIN] + (size_t)l * D * DIN + (size_t)(64 * kb) * DIN + n0, (bf16*)(sw + SW_WIN) + (size_t)drow * D + 64 * kb, DIN, D, 0}; }
        r -= I_IN;
        if (r < I_O) { const int kb = r / 16, nb = r % 16; return TItem{p->in[I_WO] + (size_t)l * D * D + (size_t)(64 * kb) * D + 64 * nb, (bf16*)(sw + SW_WO) + (size_t)(64 * nb) * D + 64 * kb, D, D, 0}; }
        r -= I_O;
        if (r < I_G) { const int kb = r / 16, nb = r % 16; return TItem{p->in[I_WG] + (size_t)l * D * D + (size_t)(64 * kb) * D + 64 * nb, (bf16*)(sw + SW_WG + (size_t)(64 * nb) * D + 64 * kb), D, D, 1}; }
        r -= I_G;
        if (r < I_PJ) { const int kb = r / 16, nb = r % 16; return TItem{p->in[I_WP] + (size_t)l * DPLE * D + (size_t)(64 * kb) * D + 64 * nb, (bf16*)(sw + SW_WP) + (size_t)(64 * nb) * DPLE + 64 * kb, D, DPLE, 0}; }
        r -= I_PJ;
        const int g = r / 4, q = r % 4, kb = q / 2, nb = q % 2;
        return TItem{p->in[I_POOLW] + ((size_t)l * 4 + g) * 128 * 128 + (size_t)(64 * kb) * 128 + 64 * nb, (bf16*)(sw + SW_PW) + (size_t)g * 128 * 128 + (size_t)(64 * nb) * 128 + 64 * kb, 128, 128, 0};
    } };
__device__ __forceinline__ void phase_cvt_small(const Params& p, LAS float* scr, int gw, int NGW, int lane) {
    constexpr int PER = 16 * 32 + 16 * 16 + 16 * 16 + 4 * 16 + 4 * 4;
    cvt_loop(GetSmall{&p}, 2 * PER, scr, gw, NGW, lane);
    for (int i = gw * 64 + lane; i < 2 * DIN; i += NGW * 64) {
        const int l = i / DIN, n = i % DIN; int src;
        if (n < 1024) { const int t = n >> 8, h = (n >> 7) & 1, j = n & 127; src = (h ? 1024 : 0) + 128 * t + j; } else if (n < 1536) src = n - 512; else src = n;
        ((float*)(p.ws + WS_SMALLW + (size_t)l * SW_LAYER + SW_BIN))[n] = p.in[I_BIN][(size_t)l * DIN + src];
    }
}
struct WTile { const float* src; unsigned char* dst; int ldw, ldt, kind; };
__device__ __forceinline__ WTile moe_tile(const Params& p, int l, int t, int& n0) {
    unsigned char* WUP = p.ws + WS_WUP; unsigned char* WDN = p.ws + WS_WDN;
    const int e = t / 48; int r = t % 48; const size_t eo = ((size_t)l * NEXP + e);
    if (r < 32) { const int m3 = r >> 4, q = r & 15, kb = q >> 2, nb = q & 3; n0 = 128 * nb;
        return WTile{(m3 ? p.in[I_W3] : p.in[I_W1]) + eo * D * DEXP + (size_t)(256 * kb) * DEXP + 128 * nb, WUP + (size_t)e * 1024 * 1024 + 256 * kb, DEXP, D, m3}; }
    r -= 32; { const int kb = r >> 3, nb = r & 7; n0 = 128 * nb;
        return WTile{p.in[I_W2] + eo * DEXP * D + (size_t)(256 * kb) * D + 128 * nb, WDN + (size_t)e * 1024 * 512 + 256 * kb, D, DEXP, 2}; }
}
__device__ __forceinline__ void wtile_load(const WTile& w, f32x4 (&v)[16], int tid) {
#pragma unroll
    for (int i = 0; i < 16; ++i) { const int idx = tid + 512 * i; v[i] = *(const f32x4*)(w.src + (size_t)(idx >> 5) * w.ldw + 4 * (idx & 31)); }
}
__device__ __forceinline__ void phase_cvt_moe(const Params& p, int l, LAS unsigned char* lds, int bx, int G, int tid) {
    LAS float* scr = (LAS float*)lds;
    int t = bx; if (t >= NEXP * 48) return;
    int n0c = 0, n0n = 0;
    WTile cur = moe_tile(p, l, t, n0c), nxt = cur; f32x4 v[16];
    wtile_load(cur, v, tid);
    const int c_lo = tid & 7, n_lo = (tid >> 3) & 7, wv = tid >> 6;
    for (;;) {
#pragma unroll
        for (int i = 0; i < 16; ++i) { const int idx = tid + 512 * i; LAS float* d = scr + (idx >> 5) * 129 + 4 * (idx & 31); d[0] = v[i].x; d[1] = v[i].y; d[2] = v[i].z; d[3] = v[i].w; }
        __syncthreads();
        const int tn = t + G; const bool more = tn < NEXP * 48;
        if (more) { nxt = moe_tile(p, l, tn, n0n); wtile_load(nxt, v, tid); }
#pragma unroll
        for (int j = 0; j < 4; ++j) { const int n = n_lo + 8 * (wv + 8 * (j & 1)), c = c_lo + 8 * (j >> 1); const LAS float* s = scr + (16 * c) * 129 + n; v4u o;
            o.x = pk4_fp8(s[0 * 129] * W8_SCALE, s[1 * 129] * W8_SCALE, s[2 * 129] * W8_SCALE, s[3 * 129] * W8_SCALE); o.y = pk4_fp8(s[4 * 129] * W8_SCALE, s[5 * 129] * W8_SCALE, s[6 * 129] * W8_SCALE, s[7 * 129] * W8_SCALE);
            o.z = pk4_fp8(s[8 * 129] * W8_SCALE, s[9 * 129] * W8_SCALE, s[10 * 129] * W8_SCALE, s[11 * 129] * W8_SCALE); o.w = pk4_fp8(s[12 * 129] * W8_SCALE, s[13 * 129] * W8_SCALE, s[14 * 129] * W8_SCALE, s[15 * 129] * W8_SCALE);
            const int nn = n0c + n, drow = cur.kind == 2 ? nn : pair_row(nn) + (cur.kind == 1 ? 128 : 0);
            *(v4u*)(cur.dst + (size_t)drow * cur.ldt + 16 * c) = o; }
        __syncthreads();
        if (!more) break;
        cur = nxt; t = tn; n0c = n0n;
    }
}
__device__ __forceinline__ void ln_row2(const float* xrow, const float* g, const float* b, bf16* hrow, int lane) {
    const f32x4* xr = (const f32x4*)xrow + lane;
    f32x4 v[2][4]; float s[2] = {0.f, 0.f};
#pragma unroll
    for (int q = 0; q < 2; ++q)
#pragma unroll
        for (int j = 0; j < 4; ++j) v[q][j] = xr[q * (D / 4) + 64 * j];
#pragma unroll
    for (int q = 0; q < 2; ++q) {
#pragma unroll
        for (int j = 0; j < 4; ++j) s[q] += (v[q][j].x + v[q][j].y) + (v[q][j].z + v[q][j].w);
        const float mean = wave_sum(s[q]) * (1.f / D); float s2 = 0.f;
#pragma unroll
        for (int j = 0; j < 4; ++j) { v[q][j] = v[q][j] - mean; s2 += (v[q][j].x * v[q][j].x + v[q][j].y * v[q][j].y) + (v[q][j].z * v[q][j].z + v[q][j].w * v[q][j].w); }
        const float rstd = 1.f / sqrtf(wave_sum(s2) * (1.f / D) + LN_EPS);
#pragma unroll
        for (int j = 0; j < 4; ++j) { const f32x4 gg = ((const f32x4*)g)[lane + 64 * j], bb = ((const f32x4*)b)[lane + 64 * j];
            const f32x4 o = v[q][j] * rstd * gg + bb;
            v2u w; w.x = pk2(o.x, o.y); w.y = pk2(o.z, o.w); ((v2u*)hrow)[q * (D / 4) + lane + 64 * j] = w; } }
}
__device__ __forceinline__ void phase_ln0_p(const Params& p, int gw, int NGW, int lane) {
    bf16* XH0 = (bf16*)(p.ws + WS_XH0);
    for (int m = 2 * gw; m < NTOK; m += 2 * NGW) ln_row2(p.in[I_X] + (size_t)m * D, p.in[I_LN0G], p.in[I_LN0B], XH0 + (size_t)m * D, lane);
    bf16* PB = (bf16*)(p.ws + WS_PB);
    for (size_t i0 = (size_t)gw * 256; i0 < (size_t)2 * NTOK * DPLE / 8; i0 += (size_t)NGW * 256) {
        f32x4 a[4], b[4];
#pragma unroll
        for (int q = 0; q < 4; ++q) { const size_t i = i0 + 64 * q + lane; a[q] = ((const f32x4*)p.in[I_P])[2 * i]; b[q] = ((const f32x4*)p.in[I_P])[2 * i + 1]; }
#pragma unroll
        for (int q = 0; q < 4; ++q) { const size_t i = i0 + 64 * q + lane; v4u o; o.x = pk2(a[q].x, a[q].y); o.y = pk2(a[q].z, a[q].w); o.z = pk2(b[q].x, b[q].y); o.w = pk2(b[q].z, b[q].w); ((v4u*)PB)[i] = o; } }
    for (int i = gw * 64 + lane; i < 2 * 48 * D; i += NGW * 64) {
        const int l = i / (48 * D), n = (i / D) % 48, k = i % D; float w = 0.f;
        if (n < 4) w = p.in[I_WRG][((size_t)l * D + k) * 4 + n]; else if (n < 36) w = p.in[I_WRE][(((size_t)l * 4 + ((n - 4) >> 3)) * D + k) * 8 + ((n - 4) & 7)];
        const unsigned h = f2bf(w); const float r = w - __builtin_bit_cast(float, h << 16);
        bf16* WR = (bf16*)(p.ws + WS_SMALLW + (size_t)l * SW_LAYER + SW_WR); WR[n * D + k] = (bf16)h; WR[48 * D + n * D + k] = (bf16)f2bf(r); }
}

namespace pg8 {
typedef unsigned u32x4 __attribute__((ext_vector_type(4)));
typedef int v4i32 __attribute__((ext_vector_type(4)));
typedef int v8i32 __attribute__((ext_vector_type(8)));
constexpr int BM = 256, BK = 64, HALF = 128, HTB = HALF * BK * 2, STAGE_BYTES = 8 * HTB, NXCD = 8, WGM = 8;
__device__ __forceinline__ int lds_byte(int r, int c) { const int st = (r >> 4) * 2 + (c >> 5), rr = r & 15, cc = c & 31, ob = rr * 64 + cc * 2; return st * 1024 + (ob ^ (((ob >> 9) & 1) << 5)); }
__device__ __forceinline__ void stage_rc(int b, int& R, int& C) { const int st = b / 1024, sb = b % 1024, swz = sb ^ (((sb >> 9) & 1) << 5); R = (st >> 1) * 16 + swz / 64; C = (st & 1) * 32 + (swz % 64) / 2; }
__device__ __forceinline__ int perm32(int rho) { const int n = rho >> 4, i = rho & 15; return 8 * (i >> 2) + 4 * n + (i & 3); }
__device__ __forceinline__ unsigned cvt_pk_bf16(float lo, float hi) { unsigned r; asm volatile("v_cvt_pk_bf16_f32 %0, %1, %2" : "=v"(r) : "v"(lo), "v"(hi)); return r; }

struct Unit { int pm, pn, e, r0, ce; };

struct DenseOrder {
    static constexpr bool GATHER = false;
    int nM, nN, nwg, G, c, K; const char* A; const char* Bt;
    __device__ __forceinline__ void init(const bf16* A_, const bf16* Bt_, int M, int N, int K_, int G_, int c_) { A = (const char*)A_; Bt = (const char*)Bt_; nM = M / BM; nN = N / BM; nwg = nM * nN; G = G_; c = c_; K = K_; }
    __device__ __forceinline__ bool next(int i, Unit& u) const {
        const long L = (long)i * G + c; if (L >= nwg) return false;
        int wgid = (int)L; { const int q = nwg / NXCD, r = nwg % NXCD, xcd = wgid % NXCD, off = wgid / NXCD; wgid = (xcd < r ? xcd * (q + 1) : r * (q + 1) + (xcd - r) * q) + off; }
        const int nig = WGM * nN, gid = wgid / nig, fm = gid * WGM, gsz = (nM - fm) < WGM ? (nM - fm) : WGM;
        u.pm = fm + ((wgid % nig) % gsz); u.pn = (wgid % nig) / gsz; u.e = 0; u.r0 = 0; u.ce = 0; return true;
    }
    __device__ __forceinline__ const char* a_base(const Unit& u) const { return A + (size_t)u.pm * BM * K * 2; }
    __device__ __forceinline__ const char* b_base(const Unit& u) const { return Bt + (size_t)u.pn * BM * K * 2; }
    __device__ __forceinline__ void a_offs(const Unit&, unsigned (&v)[2][2], int) const {}
};
struct ListOrder {
    static constexpr bool GATHER = false;
    int na, ua, ub0, lim, K; const char* A; const char* Bt;
    __device__ __forceinline__ bool next(int i, Unit& u) const {
        int id; if (i < na) id = ua; else { id = ub0 + 256 * (i - na); if (ub0 < 0 || id >= lim) return false; }
        u.pm = id >> 2; u.pn = id & 3; u.e = 0; u.r0 = 0; u.ce = 0; return true;
    }
    __device__ __forceinline__ const char* a_base(const Unit& u) const { return A + (size_t)u.pm * BM * K * 2; }
    __device__ __forceinline__ const char* b_base(const Unit& u) const { return Bt + (size_t)u.pn * BM * K * 2; }
    __device__ __forceinline__ void a_offs(const Unit&, unsigned (&v)[2][2], int) const {}
};
template <bool GATHER_> struct MoeOrder {
    static constexpr bool GATHER = GATHER_;
    const LAS int* tb; const LAS int* ct; const LAS int* t2e;
    int T4, G, c, K; const char* A; const char* W; size_t wstride; const int* list;
    __device__ __forceinline__ bool next(int i, Unit& u) const {
        const int L = i * G + c; if (L >= T4) return false;
        const int mt = L >> 2, e = t2e[mt];
        u.pm = mt; u.pn = L & 3; u.e = e; u.r0 = 256 * (mt - tb[e]); u.ce = ct[e]; return true;
    }
    __device__ __forceinline__ const char* a_base(const Unit& u) const { return GATHER ? A : A + (size_t)u.pm * BM * K * 2; }
    __device__ __forceinline__ const char* b_base(const Unit& u) const { return W + (size_t)u.e * wstride + (size_t)u.pn * BM * K * 2; }
    __device__ __forceinline__ void a_offs(const Unit& u, unsigned (&v)[2][2], int tid) const {
#pragma unroll
        for (int i = 0; i < 2; ++i) { int R, C; stage_rc(tid * 16 + i * 8192, R, C);
#pragma unroll
            for (int h = 0; h < 2; ++h) { const int rank = u.r0 + HALF * h + R; const int tok = rank < u.ce ? (list[(size_t)u.e * LCAP + rank] >> 1) : 0;
                v[h][i] = (unsigned)(tok * K + C) * 2u; } } }
};

#define EPI_ARGS const f32x4 (&acc)[2][2][4][2], const Unit& u, int wr, int wc, int fr, int fq
__device__ __forceinline__ u32x4 pack8(const f32x4 v0, const f32x4 v1) { u32x4 w; w.x = cvt_pk_bf16(v0[0], v0[1]); w.y = cvt_pk_bf16(v0[2], v0[3]); w.z = cvt_pk_bf16(v1[0], v1[1]); w.w = cvt_pk_bf16(v1[2], v1[3]); return w; }
__device__ __forceinline__ void unpack4x2(const v4u x, f32x4& lo, f32x4& hi) {
    lo[0] = __uint_as_float(x.x << 16); lo[1] = __uint_as_float(x.x & 0xffff0000u); lo[2] = __uint_as_float(x.y << 16); lo[3] = __uint_as_float(x.y & 0xffff0000u);
    hi[0] = __uint_as_float(x.z << 16); hi[1] = __uint_as_float(x.z & 0xffff0000u); hi[2] = __uint_as_float(x.w << 16); hi[3] = __uint_as_float(x.w & 0xffff0000u); }
struct EpiPlain {
    static constexpr bool PERM = true, AFTER_DRAIN = false, FP8 = false;
    bf16* O; int ldc;
    __device__ __forceinline__ void operator()(EPI_ARGS) const {
        const int row0 = u.pm * BM + wr * 64 + fr, col0 = u.pn * BM + wc * 32 + 8 * fq;
#pragma unroll
        for (int ai = 0; ai < 2; ++ai)
#pragma unroll
            for (int m = 0; m < 4; ++m) { bf16* rowp = O + (size_t)(row0 + ai * HALF + m * 16) * ldc + col0;
#pragma unroll
                for (int bj = 0; bj < 2; ++bj) *(u32x4*)(rowp + bj * HALF) = pack8(acc[ai][bj][m][0], acc[ai][bj][m][1]); }
    }
};
struct EpiPairZ {
    static constexpr bool PERM = true, AFTER_DRAIN = false, FP8 = false;
    bf16* Z; const LAS float* bias;
    __device__ __forceinline__ void operator()(EPI_ARGS) const {
        const int row0 = u.pm * BM + wr * 64 + fr, bcol0 = u.pn * BM + wc * 32 + 8 * fq;
        f32x4 bv[2][2];
#pragma unroll
        for (int bj = 0; bj < 2; ++bj)
#pragma unroll
            for (int n = 0; n < 2; ++n) bv[bj][n] = *(const LAS f32x4*)(bias + bcol0 + bj * HALF + 4 * n);
        if (u.pn < 4) {
            const int col0 = 128 * u.pn + wc * 32 + 8 * fq;
#pragma unroll
            for (int ai = 0; ai < 2; ++ai)
#pragma unroll
                for (int m = 0; m < 4; ++m) { bf16* rowp = Z + (size_t)(row0 + ai * HALF + m * 16) * DZ + col0;
                    const f32x4 v0 = (acc[ai][0][m][0] + bv[0][0]) * (acc[ai][1][m][0] + bv[1][0]), v1 = (acc[ai][0][m][1] + bv[0][1]) * (acc[ai][1][m][1] + bv[1][1]);
                    *(u32x4*)rowp = pack8(v0, v1); }
        } else {
            const int col0 = 512 + 256 * (u.pn - 4) + wc * 32 + 8 * fq;
#pragma unroll
            for (int ai = 0; ai < 2; ++ai)
#pragma unroll
                for (int m = 0; m < 4; ++m) { bf16* rowp = Z + (size_t)(row0 + ai * HALF + m * 16) * DZ + col0;
#pragma unroll
                    for (int bj = 0; bj < 2; ++bj) *(u32x4*)(rowp + bj * HALF) = pack8(acc[ai][bj][m][0] + bv[bj][0], acc[ai][bj][m][1] + bv[bj][1]); }
        }
    }
};
__device__ __forceinline__ f32x4 silu_mul(const f32x4 a, const f32x4 b) { f32x4 o;
#pragma unroll
    for (int j = 0; j < 4; ++j) o[j] = a[j] * __builtin_amdgcn_rcpf(1.f + __expf(-a[j])) * b[j];
    return o; }
struct EpiUp {
    static constexpr bool PERM = true, AFTER_DRAIN = false, FP8 = true;
    unsigned char* H;
    __device__ __forceinline__ void operator()(EPI_ARGS) const {
        const int row0 = u.pm * BM + wr * 64 + fr, col0 = 128 * u.pn + wc * 32 + 8 * fq;
#pragma unroll
        for (int ai = 0; ai < 2; ++ai) {
            asm volatile("" ::: "memory");
#pragma unroll
            for (int m = 0; m < 4; ++m) { const f32x4 h0 = silu_mul(acc[ai][0][m][0] * (1.f / W8_SCALE), acc[ai][1][m][0] * (H8_SCALE / W8_SCALE)), h1 = silu_mul(acc[ai][0][m][1] * (1.f / W8_SCALE), acc[ai][1][m][1] * (H8_SCALE / W8_SCALE));
                v2u w; w.x = pk4_fp8(sat8(h0[0]), sat8(h0[1]), sat8(h0[2]), sat8(h0[3])); w.y = pk4_fp8(sat8(h1[0]), sat8(h1[1]), sat8(h1[2]), sat8(h1[3]));
                *(v2u*)(H + (size_t)(row0 + ai * HALF + m * 16) * DEXP + col0) = w; } }
    }
};
struct EpiGate {
    static constexpr bool PERM = true, AFTER_DRAIN = false, FP8 = true;
    bf16* PP; const float* bg;
    __device__ __forceinline__ void operator()(EPI_ARGS) const {
        const int row0 = u.pm * BM + wr * 64 + fr, col0 = u.pn * BM + wc * 32 + 8 * fq;
        f32x4 bv[2][2];
#pragma unroll
        for (int bj = 0; bj < 2; ++bj)
#pragma unroll
            for (int n = 0; n < 2; ++n) bv[bj][n] = *(const f32x4*)(bg + col0 + bj * HALF + 4 * n);
#pragma unroll
        for (int ai = 0; ai < 2; ++ai) {
            v4u pv[4][2];
#pragma unroll
            for (int m = 0; m < 4; ++m)
#pragma unroll
                for (int bj = 0; bj < 2; ++bj) pv[m][bj] = *(const v4u*)(PP + (size_t)(row0 + ai * HALF + m * 16) * D + col0 + bj * HALF);
#pragma unroll
            for (int m = 0; m < 4; ++m)
#pragma unroll
                for (int bj = 0; bj < 2; ++bj) { f32x4 p0, p1; unpack4x2(pv[m][bj], p0, p1); const f32x4 g0 = acc[ai][bj][m][0] * (1.f / W8_SCALE) + bv[bj][0], g1 = acc[ai][bj][m][1] * (1.f / W8_SCALE) + bv[bj][1]; f32x4 o0, o1;
#pragma unroll
                    for (int j = 0; j < 4; ++j) { o0[j] = __builtin_amdgcn_rcpf(1.f + __expf(-g0[j])) * p0[j]; o1[j] = __builtin_amdgcn_rcpf(1.f + __expf(-g1[j])) * p1[j]; }
                    *(u32x4*)(PP + (size_t)(row0 + ai * HALF + m * 16) * D + col0 + bj * HALF) = pack8(o0, o1); }
        }
    }
};
struct EpiDown {
    static constexpr bool PERM = true, AFTER_DRAIN = false, FP8 = true; static constexpr int NSTORE = 16;
    unsigned char* YS;
    __device__ __forceinline__ void operator()(EPI_ARGS) const {
        const int row0 = u.pm * BM + wr * 64 + fr, col0 = u.pn * BM + wc * 32 + 8 * fq; constexpr float sc = Y8_SCALE / (W8_SCALE * H8_SCALE);
#pragma unroll
        for (int ai = 0; ai < 2; ++ai)
#pragma unroll
            for (int m = 0; m < 4; ++m) { unsigned char* rowp = YS + (size_t)(row0 + ai * HALF + m * 16) * D + col0;
#pragma unroll
                for (int bj = 0; bj < 2; ++bj) { const f32x4 a = acc[ai][bj][m][0] * sc, c = acc[ai][bj][m][1] * sc; v2u w; w.x = pk4_fp8(sat8(a[0]), sat8(a[1]), sat8(a[2]), sat8(a[3])); w.y = pk4_fp8(sat8(c[0]), sat8(c[1]), sat8(c[2]), sat8(c[3])); *(v2u*)(rowp + bj * HALF) = w; } }
    }
};

struct EpiRes {
    static constexpr bool PERM = true, AFTER_DRAIN = false, FP8 = false;
    const bf16* xin; bf16* Y;
    __device__ __forceinline__ void operator()(EPI_ARGS) const {
        const int row0 = u.pm * BM + wr * 64 + fr, col0 = u.pn * BM + wc * 32 + 8 * fq;
#pragma unroll
        for (int ai = 0; ai < 2; ++ai) {
            v4u xv[4][2];
#pragma unroll
            for (int m = 0; m < 4; ++m)
#pragma unroll
                for (int bj = 0; bj < 2; ++bj) xv[m][bj] = *(const v4u*)(xin + (size_t)(row0 + ai * HALF + m * 16) * D + col0 + bj * HALF);
#pragma unroll
            for (int m = 0; m < 4; ++m)
#pragma unroll
                for (int bj = 0; bj < 2; ++bj) { f32x4 lo, hi; unpack4x2(xv[m][bj], lo, hi);
                    *(u32x4*)(Y + (size_t)(row0 + ai * HALF + m * 16) * D + col0 + bj * HALF) = pack8(ALPHA * lo + acc[ai][bj][m][0], ALPHA * hi + acc[ai][bj][m][1]); }
        }
    }
};

template <class Epi, class Sched>
__device__ __forceinline__ void gemm_phase(LAS unsigned char* lds, const int K, const Sched& S, const Epi& E) {
    int tid = threadIdx.x; asm volatile("" : "+v"(tid));
    const int wid = __builtin_amdgcn_readfirstlane(tid >> 6), lane = tid & 63, wr = wid >> 2, wc = wid & 3, fr = lane & 15, fq = lane >> 4;
    const int nt = K / BK;
    unsigned voffA[2], voffB[2];
#pragma unroll
    for (int i = 0; i < 2; ++i) { int R, C; stage_rc(tid * 16 + i * 8192, R, C); const int Rb = Epi::PERM ? ((R & ~31) + perm32(R & 31)) : R; voffA[i] = (unsigned)(R * K + C) * 2u; voffB[i] = (unsigned)(Rb * K + C) * 2u; }
    asm volatile("" : "+v"(voffA[0]), "+v"(voffA[1]), "+v"(voffB[0]), "+v"(voffB[1]));
    const size_t kstep = (size_t)(BK * 2);
    const size_t hstep = (size_t)HALF * K * 2;
    const unsigned ldsw = (unsigned)wid * 1024u;
    const int aoff = lds_byte(wr * 64 + fr, fq * 8), boff = lds_byte(wc * 32 + fr, fq * 8);
#define PG8_SA(b, h) (((b) * 2 + (h)) * HTB)
#define PG8_SB(b, h) ((4 + (b) * 2 + (h)) * HTB)
#define PG8_STAGE_B(bufoff, gbase) do { _Pragma("unroll") for (int _i = 0; _i < 2; ++_i) \
        __builtin_amdgcn_global_load_lds((const unsigned*)((const char*)(gbase) + voffB[_i]), (LAS unsigned*)(lds + (bufoff) + ldsw + _i * 8192), 16, 0, 0); } while (0)
#define PG8_STAGE_A(bufoff, gbase, VO, h) do { _Pragma("unroll") for (int _i = 0; _i < 2; ++_i) { \
        if constexpr (Sched::GATHER) __builtin_amdgcn_global_load_lds((const unsigned*)((const char*)(gbase) + (VO)[h][_i]), (LAS unsigned*)(lds + (bufoff) + ldsw + _i * 8192), 16, 0, 0); \
        else __builtin_amdgcn_global_load_lds((const unsigned*)((const char*)(gbase) + (h) * hstep + voffA[_i]), (LAS unsigned*)(lds + (bufoff) + ldsw + _i * 8192), 16, 0, 0); } } while (0)
#define PG8_LDA(dst, b, h) do { _Pragma("unroll") for (int m = 0; m < 4; ++m) { const LAS unsigned char* _p = lds + PG8_SA(b, h) + aoff + m * 2048; \
        dst[m] = __builtin_shufflevector(*(const LAS v4i32*)_p, *(const LAS v4i32*)(_p + 1024), 0, 1, 2, 3, 4, 5, 6, 7); } } while (0)
#define PG8_LDB(dst, b, h) do { _Pragma("unroll") for (int n = 0; n < 2; ++n) { const LAS unsigned char* _p = lds + PG8_SB(b, h) + boff + n * 2048; \
        dst[n] = __builtin_shufflevector(*(const LAS v4i32*)_p, *(const LAS v4i32*)(_p + 1024), 0, 1, 2, 3, 4, 5, 6, 7); } } while (0)
#define PG8_HALF(x, k) __builtin_bit_cast(bf16x8, __builtin_shufflevector((x), (x), 4 * (k), 4 * (k) + 1, 4 * (k) + 2, 4 * (k) + 3))
#define PG8_MMA(ai, bj, At, Bt) do { __builtin_amdgcn_s_setprio(1); _Pragma("unroll") for (int m = 0; m < 4; ++m) _Pragma("unroll") for (int n = 0; n < 2; ++n) { \
        if constexpr (Epi::FP8) asm volatile("v_mfma_f32_16x16x128_f8f6f4 %0, %1, %2, %0" : "+v"(acc[ai][bj][m][n]) : "v"(Bt[n]), "v"(At[m]));   \
        else { acc[ai][bj][m][n] = __builtin_amdgcn_mfma_f32_16x16x32_bf16(PG8_HALF(Bt[n], 0), PG8_HALF(At[m], 0), acc[ai][bj][m][n], 0, 0, 0); \
               acc[ai][bj][m][n] = __builtin_amdgcn_mfma_f32_16x16x32_bf16(PG8_HALF(Bt[n], 1), PG8_HALF(At[m], 1), acc[ai][bj][m][n], 0, 0, 0); } } \
        __builtin_amdgcn_s_setprio(0); } while (0)
#define PG8_WAIT_V(n) asm volatile("s_waitcnt vmcnt(" #n ")" ::: "memory")
#define PG8_WAIT_L(n) asm volatile("s_waitcnt lgkmcnt(" #n ")" ::: "memory")
#define PG8_BAR __builtin_amdgcn_s_barrier()
#define PG8_SCHED __builtin_amdgcn_sched_barrier(0)
    Unit cur, nxt; int ui = 0;
    if (!S.next(0, cur)) return;
    f32x4 acc[2][2][4][2];
#pragma unroll
    for (int a = 0; a < 2; ++a)
#pragma unroll
        for (int b = 0; b < 2; ++b)
#pragma unroll
            for (int m = 0; m < 4; ++m)
#pragma unroll
                for (int n = 0; n < 2; ++n) acc[a][b][m][n] = (f32x4){0.f, 0.f, 0.f, 0.f};
    v8i32 At[4], B0[2], B1[2];
    unsigned vA[2][2], vN[2][2];
    S.a_offs(cur, vA, tid);
    const char* cA = S.a_base(cur); const char* cB = S.b_base(cur);
    PG8_STAGE_B(PG8_SB(0, 0), cB); PG8_STAGE_B(PG8_SB(0, 1), cB + hstep); PG8_STAGE_A(PG8_SA(0, 0), cA, vA, 0); PG8_STAGE_A(PG8_SA(0, 1), cA, vA, 1);
    if (wr == 1) PG8_BAR;
    PG8_WAIT_V(2); PG8_BAR;
    PG8_STAGE_B(PG8_SB(1, 0), cB + kstep); PG8_STAGE_A(PG8_SA(1, 0), cA + kstep, vA, 0); PG8_STAGE_B(PG8_SB(1, 1), cB + hstep + kstep);
    PG8_WAIT_V(6); PG8_BAR;
    for (;;) {
        const bool has_next = S.next(ui + 1, nxt);
        const char* nA = has_next ? S.a_base(nxt) : cA; const char* nB = has_next ? S.b_base(nxt) : cB;
        if constexpr (Sched::GATHER) { if (has_next) S.a_offs(nxt, vN, tid); else {
#pragma unroll
            for (int h = 0; h < 2; ++h)
#pragma unroll
                for (int i = 0; i < 2; ++i) vN[h][i] = vA[h][i]; } }
#pragma nounroll
        for (int t = 0; t < nt; t += 2) {
            const bool last = (t == nt - 2);
            asm volatile("" : "+v"(voffA[0]), "+v"(voffA[1]), "+v"(voffB[0]), "+v"(voffB[1]));
            const char* a1 = cA + (size_t)(t + 1) * kstep;
            const char* a2 = last ? nA : cA + (size_t)(t + 2) * kstep; const char* b2 = last ? nB : cB + (size_t)(t + 2) * kstep;
            const char* a3 = a2 + kstep; const char* b3 = b2 + kstep;
            PG8_LDB(B0, 0, 0); PG8_LDB(B1, 0, 1); PG8_SCHED; PG8_LDA(At, 0, 0); PG8_STAGE_A(PG8_SA(1, 1), a1, vA, 1);
            if constexpr (Sched::GATHER) { if (last) {
#pragma unroll
                for (int h = 0; h < 2; ++h)
#pragma unroll
                    for (int i = 0; i < 2; ++i) vA[h][i] = vN[h][i]; } }
            PG8_WAIT_V(8); PG8_WAIT_L(0); PG8_BAR; PG8_MMA(0, 0, At, B0); PG8_MMA(0, 1, At, B1); PG8_BAR; PG8_SCHED;
            PG8_LDA(At, 0, 1); PG8_STAGE_B(PG8_SB(0, 0), b2); PG8_STAGE_B(PG8_SB(0, 1), b2 + hstep); PG8_STAGE_A(PG8_SA(0, 0), a2, vA, 0);
            PG8_WAIT_V(8); PG8_WAIT_L(0); PG8_BAR; PG8_MMA(1, 0, At, B0); PG8_MMA(1, 1, At, B1); PG8_BAR; PG8_SCHED;
            PG8_LDB(B0, 1, 0); PG8_LDB(B1, 1, 1); PG8_SCHED; PG8_LDA(At, 1, 0); PG8_STAGE_A(PG8_SA(0, 1), a2, vA, 1);
            PG8_WAIT_V(8); PG8_WAIT_L(0); PG8_BAR; PG8_MMA(0, 0, At, B0); PG8_MMA(0, 1, At, B1); PG8_BAR; PG8_SCHED;
            PG8_LDA(At, 1, 1); PG8_STAGE_B(PG8_SB(1, 0), b3); PG8_STAGE_B(PG8_SB(1, 1), b3 + hstep); PG8_STAGE_A(PG8_SA(1, 0), a3, vA, 0);
            PG8_WAIT_V(8); PG8_WAIT_L(0); PG8_BAR; PG8_MMA(1, 0, At, B0); PG8_MMA(1, 1, At, B1); PG8_BAR; PG8_SCHED;
        }
        if constexpr (Epi::FP8) asm volatile("s_nop 15\n\ts_nop 15" ::: "memory");
        if (wr == 0) PG8_BAR;
        if constexpr (!Epi::AFTER_DRAIN) { int t2 = tid; asm volatile("" : "+v"(t2));
            const int w2 = __builtin_amdgcn_readfirstlane(t2 >> 6), l2 = t2 & 63; E(acc, cur, w2 >> 2, w2 & 3, l2 & 15, l2 >> 4); }
        if (!has_next) break;
#pragma unroll
        for (int a = 0; a < 2; ++a)
#pragma unroll
            for (int b = 0; b < 2; ++b)
#pragma unroll
                for (int m = 0; m < 4; ++m)
#pragma unroll
                    for (int n = 0; n < 2; ++n) acc[a][b][m][n] = (f32x4){0.f, 0.f, 0.f, 0.f};
        cur = nxt; cA = nA; cB = nB; ++ui;
        if (wr == 1) PG8_BAR;
    }
    PG8_WAIT_V(0);
    PG8_BAR;
#undef PG8_SA
#undef PG8_SB
#undef PG8_STAGE_A
#undef PG8_STAGE_B
#undef PG8_LDA
#undef PG8_LDB
#undef PG8_MMA
#undef PG8_HALF
#undef PG8_WAIT_V
#undef PG8_WAIT_L
#undef PG8_BAR
#undef PG8_SCHED
}
}
constexpr int NWAVES = 8;
constexpr int RING_BYTES = 131072, EXT_OFF = 139264, LDS_BYTES = 155648;
constexpr int EXT_MISC = 0, EXT_TB = 256, EXT_CT = 512, EXT_T2E = 768, EXT_BIAS = 4096;
constexpr int CW_BAR = 4096;
constexpr int N_PHASES = 17;

#define GAS __attribute__((address_space(1)))
typedef GAS unsigned gu32;
#define RLX_AGENT __ATOMIC_RELAXED, __HIP_MEMORY_SCOPE_AGENT
#define VM_WAIT() asm volatile("s_waitcnt vmcnt(0)" ::: "memory")

#define XB_TMO      128
#define XB_XCNT(j)  (256  + 64 * (j))
#define XB_XSUB(j)  (1280 + 64 * (j))
#define XB_XGEN(j)  (2304 + 64 * (j))
#define XB_TOP      3328
#define XB_TOPGEN   3392
#define XCD_BAR_WORDS 3456
#define XB_SPIN_CAP (1u << 18)
__device__ __forceinline__ unsigned xb_ld(unsigned* p)              { return __hip_atomic_load(p, __ATOMIC_RELAXED, __HIP_MEMORY_SCOPE_AGENT); }
__device__ __forceinline__ unsigned xb_add(unsigned* p, unsigned v) { return __hip_atomic_fetch_add(p, v, __ATOMIC_RELAXED, __HIP_MEMORY_SCOPE_AGENT); }
__device__ __forceinline__ unsigned xb_xcc_id() { return (unsigned)__builtin_amdgcn_s_getreg((3 << 11) | 20) & 0xFu; }
#define XB_SPIN(cond, bar) do { unsigned _sp = 0; while (cond) { __builtin_amdgcn_s_sleep(1); \
    if ((++_sp & 255u) == 0u) { if (xb_ld(&(bar)[XB_TMO])) break; if (_sp > XB_SPIN_CAP) { atomicAdd(&(bar)[XB_TMO], 1u); break; } } } } while (0)
struct XcdBarrier { unsigned* bar; unsigned x; volatile LAS unsigned* st; };
__device__ __forceinline__ XcdBarrier xcd_barrier_post(unsigned* bar, volatile LAS unsigned* st) {
    XcdBarrier b; b.bar = bar; b.x = xb_xcc_id(); b.st = st;
    if (threadIdx.x == 0) (void)xb_add(&bar[XB_XCNT(b.x)], 1u);
    return b;
}
__device__ __forceinline__ void xcd_barrier_complete(unsigned* bar, unsigned x, unsigned& nloc, unsigned& nx) {
    const unsigned G = gridDim.x * gridDim.y * gridDim.z;
    unsigned sum, cnt, mine, sp = 0u;
    for (;;) {
        sum = 0u; cnt = 0u; mine = 0u;
#pragma unroll
        for (unsigned j = 0; j < 16; ++j) { const unsigned c = xb_ld(&bar[XB_XCNT(j)]); sum += c; cnt += (c > 0u) ? 1u : 0u; mine = (j == x) ? c : mine; }
        if (sum == G) break;
        __builtin_amdgcn_s_sleep(1);
        if ((++sp & 255u) == 0u) { if (xb_ld(&bar[XB_TMO])) break; if (sp > XB_SPIN_CAP) { atomicAdd(&bar[XB_TMO], 1u); break; } }
    }
    nloc = mine > 0u ? mine : 1u; nx = cnt > 0u ? cnt : 1u;
}
__device__ __forceinline__ void xcd_barrier(const XcdBarrier& b) {
    asm volatile("s_waitcnt vmcnt(0)" ::: "memory");
    __syncthreads();
    if (threadIdx.x == 0) {
        unsigned* bar = b.bar;
        __builtin_amdgcn_s_waitcnt(0);
        unsigned nloc = b.st[0], nx = b.st[1];
        if (nloc == 0u) { xcd_barrier_complete(bar, b.x, nloc, nx); b.st[0] = nloc; b.st[1] = nx; }
        const unsigned old = xb_add(&bar[XB_XSUB(b.x)], 1u);
        const unsigned gen = old / nloc;
        if (old + 1u == (gen + 1u) * nloc) {
            __builtin_amdgcn_fence(__ATOMIC_RELEASE, "agent");
            asm volatile("s_waitcnt vmcnt(0)" ::: "memory");
            const unsigned og = xb_add(&bar[XB_TOP], 1u);
            const unsigned tg = og / nx;
            if (og + 1u == (tg + 1u) * nx) xb_add(&bar[XB_TOPGEN], 1u);
            else XB_SPIN(xb_ld(&bar[XB_TOPGEN]) == tg, bar);
            __builtin_amdgcn_fence(__ATOMIC_ACQUIRE, "agent");
            xb_add(&bar[XB_XGEN(b.x)], 1u);
            asm volatile("s_waitcnt vmcnt(0)" ::: "memory");
        } else {
            XB_SPIN(xb_ld(&bar[XB_XGEN(b.x)]) == gen, bar);
            __builtin_amdgcn_fence(__ATOMIC_ACQUIRE, "agent");
            asm volatile("s_waitcnt vmcnt(0)" ::: "memory");
        }
    }
    __syncthreads();
}

__device__ __forceinline__ int moe_tables(const unsigned* cnt, LAS unsigned char* ext, int tid) {
    LAS int* tb = (LAS int*)(ext + EXT_TB); LAS int* ct = (LAS int*)(ext + EXT_CT); LAS int* t2e = (LAS int*)(ext + EXT_T2E);
    __syncthreads();
    if (tid < NEXP) ct[tid] = (int)__hip_atomic_load(cnt + tid, RLX_AGENT);
    __syncthreads();
    if (tid == 0) { int t = 0; for (int e = 0; e < NEXP; ++e) { tb[e] = t; t += (ct[e] + 255) >> 8; } tb[NEXP] = t; }
    __syncthreads();
    const int T = tb[NEXP];
    for (int mt = tid; mt < T; mt += NWAVES * 64) { int e = 0; while (e < NEXP - 1 && mt >= tb[e + 1]) ++e; t2e[mt] = e; }
    __syncthreads();
    return 4 * T;
}

__device__ __forceinline__ void unpack8(const v4u x, float (&f)[8]) {
    f[0] = __uint_as_float(x.x << 16); f[1] = __uint_as_float(x.x & 0xffff0000u); f[2] = __uint_as_float(x.y << 16); f[3] = __uint_as_float(x.y & 0xffff0000u);
    f[4] = __uint_as_float(x.z << 16); f[5] = __uint_as_float(x.z & 0xffff0000u); f[6] = __uint_as_float(x.w << 16); f[7] = __uint_as_float(x.w & 0xffff0000u); }
__device__ __forceinline__ void phase_mixer(const Params& p, int l, LAS unsigned char* lds, int vcu, int G, int wave, int lane) {
    constexpr int RU = 64, PITCH = 1040;
    const bf16* Z = (const bf16*)(p.ws + WS_Z); bf16* A2 = (bf16*)(p.ws + WS_A2);
    const float* cw = p.in[I_CONVW] + (size_t)l * 3 * 512; const float* ps = p.in[I_PSCALE] + (size_t)l * 512;
    const bf16* PW = (const bf16*)(p.ws + WS_SMALLW + (size_t)l * SW_LAYER + SW_PW);
    const int c8 = 8 * lane, fr = lane & 15, fq = lane >> 4;
    float w0[8], w1[8], w2[8];
#pragma unroll
    for (int j = 0; j < 8; ++j) { w0[j] = cw[c8 + j]; w1[j] = cw[512 + c8 + j]; w2[j] = cw[1024 + c8 + j]; }
    const int pg = lane >> 4, PWIN = 2 << pg, left = PWIN >> 1, right = PWIN - 1 - left;
    const int g2 = wave >> 1, dh = wave & 1;
    bf16x8 Bf[4][4];
#pragma unroll
    for (int nb = 0; nb < 4; ++nb)
#pragma unroll
        for (int ks = 0; ks < 4; ++ks) { const int d = 64 * dh + 16 * (fr >> 2) + 4 * nb + (fr & 3); Bf[nb][ks] = *(const bf16x8*)(PW + ((size_t)g2 * 128 + d) * 128 + 32 * ks + 8 * fq); }
    float sc[16];
#pragma unroll
    for (int q = 0; q < 16; ++q) sc[q] = ps[128 * g2 + 64 * dh + 16 * fq + q];
    for (int unit = vcu; unit < NTOK / RU; unit += G) {
        const int t0 = unit * RU, tw = t0 + 8 * wave;
        {
            const int tt0 = tw & (SEQ - 1);
            v4u vr[10], gbr[8];
#pragma unroll
            for (int r = 0; r < 10; ++r) { const int tt = tt0 - 1 + r; vr[r] = (v4u){0u, 0u, 0u, 0u}; if (tt >= 0 && tt < SEQ) vr[r] = *(const v4u*)(Z + (size_t)(tw - 1 + r) * DZ + c8); }
#pragma unroll
            for (int r = 0; r < 8; ++r) gbr[r] = *(const v4u*)(Z + (size_t)(tw + r) * DZ + 512 + c8);
#pragma unroll
            for (int r = 0; r < 8; ++r) {
                float a[8], b[8], c[8], g[8], o[8]; unpack8(vr[r], a); unpack8(vr[r + 1], b); unpack8(vr[r + 2], c); unpack8(gbr[r], g);
#pragma unroll
                for (int j = 0; j < 8; ++j) o[j] = g[j] * (w0[j] * a[j] + w1[j] * b[j] + w2[j] * c[j]);
                v4u ov; ov.x = pk2(o[0], o[1]); ov.y = pk2(o[2], o[3]); ov.z = pk2(o[4], o[5]); ov.w = pk2(o[6], o[7]);
                *(v4u*)(A2 + (size_t)(tw + r) * D + c8) = ov; }
        }
        {
            const bf16* U = Z + 1024 + c8; const int tt0 = tw & (SEQ - 1); const size_t seq0 = (size_t)(tw - tt0);
            float S[8];
#pragma unroll
            for (int j = 0; j < 8; ++j) S[j] = 0.f;
            { v4u ld[16];
#pragma unroll
              for (int q = 0; q < 16; ++q) { const int tq = tt0 - left + q, tc = tq < 0 ? 0 : (tq > SEQ - 1 ? SEQ - 1 : tq); ld[q] = *(const v4u*)(U + (seq0 + tc) * DZ); }
#pragma unroll
              for (int q = 0; q < 16; ++q) { const int tq = tt0 - left + q; const float mk = (q < PWIN && tq >= 0 && tq < SEQ) ? 1.f : 0.f; float f[8]; unpack8(ld[q], f);
#pragma unroll
                  for (int j = 0; j < 8; ++j) S[j] += mk * f[j]; } }
            v4u lin[8], lout[8], lself[8];
#pragma unroll
            for (int r = 0; r < 8; ++r) { const int tt = tt0 + r, tin = tt + right, tout = tt - 1 - left;
                lself[r] = *(const v4u*)(U + (seq0 + tt) * DZ);
                lin[r] = *(const v4u*)(U + (seq0 + (tin > SEQ - 1 ? SEQ - 1 : tin)) * DZ); lout[r] = *(const v4u*)(U + (seq0 + (tout < 0 ? 0 : tout)) * DZ); }
#pragma unroll
            for (int r = 0; r < 8; ++r) { const int tt = tt0 + r;
                if (r > 0) { const int tin = tt + right, tout = tt - 1 - left; const float mi = tin < SEQ ? 1.f : 0.f, mo = tout >= 0 ? 1.f : 0.f; float fi[8], fo[8]; unpack8(lin[r], fi); unpack8(lout[r], fo);
#pragma unroll
                    for (int j = 0; j < 8; ++j) S[j] += mi * fi[j] - mo * fo[j]; }
                const int lo = tt - left < 0 ? 0 : tt - left, hi = tt + right > SEQ - 1 ? SEQ - 1 : tt + right; const float inv = 1.f / (float)(hi - lo + 1);
                float f[8], o[8]; unpack8(lself[r], f);
#pragma unroll
                for (int j = 0; j < 8; ++j) o[j] = S[j] * inv - f[j];
                v4u ov; ov.x = pk2(o[0], o[1]); ov.y = pk2(o[2], o[3]); ov.z = pk2(o[4], o[5]); ov.w = pk2(o[6], o[7]);
                *(LAS v4u*)(lds + (8 * wave + r) * PITCH + 16 * lane) = ov; }
        }
        __syncthreads();
#pragma unroll
        for (int mb = 0; mb < 4; ++mb) {
            f32x4 acc[4];
#pragma unroll
            for (int nb = 0; nb < 4; ++nb) acc[nb] = (f32x4){0.f, 0.f, 0.f, 0.f};
#pragma unroll
            for (int ks = 0; ks < 4; ++ks) { const bf16x8 Af = *(const LAS bf16x8*)(lds + (16 * mb + fr) * PITCH + 2 * (128 * g2 + 32 * ks + 8 * fq));
#pragma unroll
                for (int nb = 0; nb < 4; ++nb) acc[nb] = __builtin_amdgcn_mfma_f32_16x16x32_bf16(Bf[nb][ks], Af, acc[nb], 0, 0, 0); }
            bf16* op = A2 + (size_t)(t0 + 16 * mb + fr) * D + 512 + 128 * g2 + 64 * dh + 16 * fq;
            v4u o0, o1;
            o0.x = pk2(acc[0][0] * sc[0], acc[0][1] * sc[1]); o0.y = pk2(acc[0][2] * sc[2], acc[0][3] * sc[3]); o0.z = pk2(acc[1][0] * sc[4], acc[1][1] * sc[5]); o0.w = pk2(acc[1][2] * sc[6], acc[1][3] * sc[7]);
            o1.x = pk2(acc[2][0] * sc[8], acc[2][1] * sc[9]); o1.y = pk2(acc[2][2] * sc[10], acc[2][3] * sc[11]); o1.z = pk2(acc[3][0] * sc[12], acc[3][1] * sc[13]); o1.w = pk2(acc[3][2] * sc[14], acc[3][3] * sc[15]);
            *(v4u*)op = o0; *(v4u*)(op + 8) = o1;
        }
        __syncthreads();
    }
}


constexpr int RT_B = 0, RT_BPITCH = 1040, RT_GB = 99840, RT_LG = 108032, RT_EX = 134656, RT_WT = 135680, RT_LR = 136704, RT_HIST = 137728, RT_CH = 138240, RT_PART = 99840, RT_BIAS = 138752;
static_assert(RT_LG + 8 * 16 * 52 * 4 <= RT_EX && RT_CH + 512 <= RT_BIAS && RT_BIAS + 144 <= 139264, "routing LDS map");
__device__ __forceinline__ void phase_route(const Params& p, int l, LAS unsigned char* lds, int bx, int wave, int lane, int tid, size_t dofs) {
    bf16* X = (bf16*)(p.ws + WS_XH1); unsigned char* XQ = p.ws + WS_XQ;
    const bf16* WR = (const bf16*)(p.ws + WS_SMALLW + (size_t)l * SW_LAYER + SW_WR);
    const int fr = lane & 15, fq = lane >> 4, tok0 = 128 * bx + 16 * wave;
    bf16x8 af[32];
    bf16* xrow = X + (size_t)(tok0 + fr) * D + 8 * fq;
#pragma unroll
    for (int ks = 0; ks < 32; ++ks) af[ks] = *(const bf16x8*)(xrow + 32 * ks);
    { const float* g = p.in[I_LN1G] + (size_t)l * D; const float* b = p.in[I_LN1B] + (size_t)l * D;
      *(LAS f32x4*)(lds + RT_GB + 16 * tid) = tid < 256 ? *(const f32x4*)(g + 4 * tid) : *(const f32x4*)(b + 4 * (tid - 256));
      if (tid < 36) ((LAS float*)(lds + RT_BIAS))[tid] = tid < 4 ? p.in[I_BRG][l * 4 + tid] : p.in[I_BRE][l * 32 + tid - 4]; }
#define RT_LOAD_B(T, half) do { _Pragma("unroll") for (int _i = 0; _i < 12; ++_i) { const int c = tid + 512 * _i, row = c >> 6, cc = c & 63; T[_i] = *(const v4u*)(WR + (size_t)row * D + 512 * (half) + 8 * cc); } } while (0)
#define RT_PUT_B(T) do { _Pragma("unroll") for (int _i = 0; _i < 12; ++_i) { const int c = tid + 512 * _i, row = c >> 6, cc = c & 63; *(LAS v4u*)(lds + RT_B + row * RT_BPITCH + 16 * cc) = T[_i]; } } while (0)
    { v4u tb0[12]; RT_LOAD_B(tb0, 0); RT_PUT_B(tb0); }
    float s = 0.f;
#pragma unroll
    for (int ks = 0; ks < 32; ++ks) { f32x4 lo, hi; pg8::unpack4x2(__builtin_bit_cast(v4u, af[ks]), lo, hi); s += ((lo[0] + lo[1]) + (lo[2] + lo[3])) + ((hi[0] + hi[1]) + (hi[2] + hi[3])); }
    s += __shfl_xor(s, 16); s += __shfl_xor(s, 32);
#define RT_PIN() do { _Pragma("unroll") for (int _k = 0; _k < 32; ++_k) asm volatile("" : "+v"(af[_k])); } while (0)
    RT_PIN();
    const float mean = s * (1.f / D); float q = 0.f;
#pragma unroll
    for (int ks = 0; ks < 32; ++ks) { f32x4 lo, hi; pg8::unpack4x2(__builtin_bit_cast(v4u, af[ks]), lo, hi); lo = lo - mean; hi = hi - mean;
        q += ((lo[0] * lo[0] + lo[1] * lo[1]) + (lo[2] * lo[2] + lo[3] * lo[3])) + ((hi[0] * hi[0] + hi[1] * hi[1]) + (hi[2] * hi[2] + hi[3] * hi[3])); }
    q += __shfl_xor(q, 16); q += __shfl_xor(q, 32);
    const float rstd = 1.f / sqrtf(q * (1.f / D) + LN_EPS);
    RT_PIN();
    __syncthreads();
    { const LAS float* GB = (const LAS float*)(lds + RT_GB);
#pragma unroll
      for (int ks = 0; ks < 32; ++ks) { f32x4 lo, hi; pg8::unpack4x2(__builtin_bit_cast(v4u, af[ks]), lo, hi); const int k = 32 * ks + 8 * fq;
          const f32x4 g0 = *(const LAS f32x4*)(GB + k), g1 = *(const LAS f32x4*)(GB + k + 4), b0 = *(const LAS f32x4*)(GB + D + k), b1 = *(const LAS f32x4*)(GB + D + k + 4);
          const f32x4 o0 = (lo - mean) * rstd * g0 + b0, o1 = (hi - mean) * rstd * g1 + b1; const pg8::u32x4 w = pg8::pack8(o0, o1);
          af[ks] = __builtin_bit_cast(bf16x8, w); *(pg8::u32x4*)(xrow + 32 * ks) = w;
          v2u q8; q8.x = pk4_fp8(o0[0], o0[1], o0[2], o0[3]); q8.y = pk4_fp8(o1[0], o1[1], o1[2], o1[3]); *(v2u*)(XQ + (size_t)(tok0 + fr) * D + 32 * ks + 8 * fq) = q8; } }
    f32x4 acc[3];
#pragma unroll
    for (int nb = 0; nb < 3; ++nb) acc[nb] = (f32x4){0.f, 0.f, 0.f, 0.f};
#define RT_MMA(half) do { _Pragma("unroll") for (int k2 = 0; k2 < 16; ++k2) { _Pragma("unroll") for (int nb = 0; nb < 3; ++nb) { \
        const bf16x8 Bh = *(const LAS bf16x8*)(lds + RT_B + (16 * nb + fr) * RT_BPITCH + 2 * (32 * k2 + 8 * fq)), Bl = *(const LAS bf16x8*)(lds + RT_B + (48 + 16 * nb + fr) * RT_BPITCH + 2 * (32 * k2 + 8 * fq)); \
        acc[nb] = __builtin_amdgcn_mfma_f32_16x16x32_bf16(Bh, af[16 * (half) + k2], acc[nb], 0, 0, 0); acc[nb] = __builtin_amdgcn_mfma_f32_16x16x32_bf16(Bl, af[16 * (half) + k2], acc[nb], 0, 0, 0); } } } while (0)
    v4u tb1[12]; RT_LOAD_B(tb1, 1);
    RT_MMA(0);
    __syncthreads();
    RT_PUT_B(tb1);
    __syncthreads();
    RT_MMA(1);
#undef RT_LOAD_B
#undef RT_PUT_B
#undef RT_MMA
    LAS float* Lg = (LAS float*)(lds + RT_LG);
#pragma unroll
    for (int nb = 0; nb < 3; ++nb)
#pragma unroll
        for (int j = 0; j < 4; ++j) Lg[(16 * wave + fr) * 52 + 16 * nb + 4 * fq + j] = acc[nb][j];
    LDS_WAIT(); asm volatile("" ::: "memory");
    LAS int* EX = (LAS int*)(lds + RT_EX); LAS float* WT = (LAS float*)(lds + RT_WT); LAS int* LR = (LAS int*)(lds + RT_LR); LAS int* HIST = (LAS int*)(lds + RT_HIST); LAS int* CH = (LAS int*)(lds + RT_CH);
    if (lane < 16) {
        const int tk = 16 * wave + lane; const LAS float* r0 = Lg + tk * 52; const LAS float* BI = (const LAS float*)(lds + RT_BIAS);
        float lg[4];
#pragma unroll
        for (int g = 0; g < 4; ++g) lg[g] = r0[g] + BI[g];
        int gs = 0; float gm = lg[0];
#pragma unroll
        for (int g = 1; g < 4; ++g) if (lg[g] > gm) { gm = lg[g]; gs = g; }
        float den = 0.f;
#pragma unroll
        for (int g = 0; g < 4; ++g) den += __expf(lg[g] - gm);
        const float g_w = 1.f / den;
        float el[8];
#pragma unroll
        for (int e = 0; e < 8; ++e) el[e] = r0[4 + 8 * gs + e] + BI[4 + 8 * gs + e];
        int i0 = 0; float v0 = el[0];
#pragma unroll
        for (int e = 1; e < 8; ++e) if (el[e] > v0) { v0 = el[e]; i0 = e; }
        int i1 = -1; float v1 = -3.0e38f;
#pragma unroll
        for (int e = 0; e < 8; ++e) if (e != i0 && el[e] > v1) { v1 = el[e]; i1 = e; }
        const float ex = __expf(v1 - v0);
        EX[2 * tk] = gs * 8 + i0; EX[2 * tk + 1] = gs * 8 + i1; WT[2 * tk] = g_w / (1.f + ex); WT[2 * tk + 1] = g_w * ex / (1.f + ex);
    }
    __syncthreads();
    int my_e = 0, my_lr = 0;
    if (wave < 4) {
        my_e = EX[64 * wave + lane]; int my_cnt = 0;
        const unsigned long long below = (1ull << lane) - 1ull;
        for (int x = 0; x < NEXP; ++x) { const unsigned long long mk = __ballot(my_e == x); if (my_e == x) my_lr = __popcll(mk & below); if (lane == x) my_cnt = __popcll(mk); }
        if (lane < NEXP) CH[wave * NEXP + lane] = my_cnt;
    }
    __syncthreads();
    if (wave < 4) { int before = 0; for (int w = 0; w < wave; ++w) before += CH[w * NEXP + my_e]; LR[64 * wave + lane] = my_lr + before; }
    if (tid < NEXP) HIST[tid] = CH[tid] + CH[NEXP + tid] + CH[2 * NEXP + tid] + CH[3 * NEXP + tid];
    __syncthreads();
    if (tid < NEXP) ((int*)(p.ws + WS_HIST + dofs))[bx * NEXP + tid] = HIST[tid];
    if (tid < 128) { const int t = tid, tok = 128 * bx + t;
        int4 rc; rc.x = EX[2 * t]; rc.y = LR[2 * t]; rc.z = EX[2 * t + 1]; rc.w = LR[2 * t + 1]; ((int4*)(p.ws + WS_TOKREC + dofs))[tok] = rc;
        float2 w; w.x = WT[2 * t]; w.y = WT[2 * t + 1]; ((float2*)(p.ws + WS_TOKW + dofs))[tok] = w; }
    __syncthreads();
}
__device__ __forceinline__ void phase_scatter(const Params& p, int l, LAS unsigned char* lds, int bx, int G, int tid, size_t dofs, int cslot) {
    const int* hist = (const int*)(p.ws + WS_HIST + dofs);
    LAS int* PART = (LAS int*)(lds + RT_PART);
    LAS int* BASE = (LAS int*)(lds + RT_HIST); LAS int* TOT = BASE + 32;
    { const int t = tid, e = t & 31, part = t >> 5; int sb = 0, sa = 0;
      int hv[16];
#pragma unroll
      for (int q = 0; q < 16; ++q) { const int w = part * 16 + q; hv[q] = w < G ? hist[w * NEXP + e] : 0; }
#pragma unroll
      for (int q = 0; q < 16; ++q) { sa += hv[q]; if (part * 16 + q < bx) sb += hv[q]; }
      PART[part * 32 + e] = sb; PART[512 + part * 32 + e] = sa; }
    __syncthreads();
    if (tid < NEXP) { int sb = 0, sa = 0; for (int q = 0; q < 16; ++q) { sb += PART[q * 32 + tid]; sa += PART[512 + q * 32 + tid]; } BASE[tid] = sb; TOT[tid] = sa;
        if (bx == 0) ((unsigned*)(p.ws + WS_CTL))[CW_CNT + 64 * cslot + tid] = (unsigned)sa; }
    __syncthreads();
    if (tid < 128) { const int tok = 128 * bx + tid;
        int4 rc = ((const int4*)(p.ws + WS_TOKREC + dofs))[tok];
        rc.y += BASE[rc.x]; rc.w += BASE[rc.z];
        int* list = (int*)(p.ws + WS_LIST + dofs);
        list[(size_t)rc.x * LCAP + rc.y] = 2 * tok;
        list[(size_t)rc.z * LCAP + rc.w] = 2 * tok + 1;
        ((int4*)(p.ws + WS_TOKREC + dofs))[tok] = rc; }
    __syncthreads();
}


__device__ __forceinline__ void phase_ln2(const Params& p, int l, const LAS int* tb, int gw, int NGW, int lane) {
    const bf16* X1 = (const bf16*)(p.ws + WS_XH1); const bf16* PL = (const bf16*)(p.ws + WS_PP); const unsigned char* YS = p.ws + WS_YS; bf16* XO = (bf16*)(p.ws + WS_XH0);
    const int4* REC = (const int4*)(p.ws + WS_TOKREC); const float2* TW = (const float2*)(p.ws + WS_TOKW);
    const float* g = p.in[I_LN2G] + (size_t)l * D; const float* b = p.in[I_LN2B] + (size_t)l * D;
    f32x4 gg[2][2], bb[2][2];
#pragma unroll
    for (int h = 0; h < 2; ++h)
#pragma unroll
        for (int q = 0; q < 2; ++q) { gg[h][q] = *(const f32x4*)(g + 512 * h + 8 * lane + 4 * q); bb[h][q] = *(const f32x4*)(b + 512 * h + 8 * lane + 4 * q); }
    int m = 2 * gw; if (m >= NTOK) return;
    int4 rc[2]; float2 tw[2];
#pragma unroll
    for (int r = 0; r < 2; ++r) { rc[r] = REC[m + r]; tw[r] = TW[m + r]; }
    for (;;) {
        v4u xv[2][2], pv[2][2]; v2u y0[2][2], y1[2][2]; float w0[2], w1[2];
#pragma unroll
        for (int r = 0; r < 2; ++r) { const size_t s0 = (size_t)(256 * tb[rc[r].x] + rc[r].y) * D, s1 = (size_t)(256 * tb[rc[r].z] + rc[r].w) * D; w0[r] = tw[r].x * (1.f / Y8_SCALE); w1[r] = tw[r].y * (1.f / Y8_SCALE);
#pragma unroll
            for (int h = 0; h < 2; ++h) { const size_t o = (size_t)(m + r) * D + 512 * h + 8 * lane;
                xv[r][h] = *(const v4u*)(X1 + o); pv[r][h] = *(const v4u*)(PL + o); y0[r][h] = *(const v2u*)(YS + s0 + 512 * h + 8 * lane); y1[r][h] = *(const v2u*)(YS + s1 + 512 * h + 8 * lane); } }
        const int mn = m + 2 * NGW; const bool more = mn < NTOK;
        if (more) {
#pragma unroll
            for (int r = 0; r < 2; ++r) { rc[r] = REC[mn + r]; tw[r] = TW[mn + r]; } }
#pragma unroll
        for (int r = 0; r < 2; ++r) {
            f32x4 v[2][2]; float s = 0.f;
#pragma unroll
            for (int h = 0; h < 2; ++h) { f32x4 x0, x1, p0, p1, a0, a1, c0, c1; pg8::unpack4x2(xv[r][h], x0, x1); pg8::unpack4x2(pv[r][h], p0, p1); unpack8_fp8(y0[r][h], a0, a1); unpack8_fp8(y1[r][h], c0, c1);
                v[h][0] = ALPHA * x0 + (w0[r] * a0 + w1[r] * c0) + p0; v[h][1] = ALPHA * x1 + (w0[r] * a1 + w1[r] * c1) + p1;
                s += (v[h][0].x + v[h][0].y) + (v[h][0].z + v[h][0].w) + (v[h][1].x + v[h][1].y) + (v[h][1].z + v[h][1].w); }
            const float mean = wave_sum(s) * (1.f / D); float s2 = 0.f;
#pragma unroll
            for (int h = 0; h < 2; ++h)
#pragma unroll
                for (int q = 0; q < 2; ++q) { v[h][q] = v[h][q] - mean; s2 += (v[h][q].x * v[h][q].x + v[h][q].y * v[h][q].y) + (v[h][q].z * v[h][q].z + v[h][q].w * v[h][q].w); }
            const float rstd = 1.f / sqrtf(wave_sum(s2) * (1.f / D) + LN_EPS);
#pragma unroll
            for (int h = 0; h < 2; ++h) { const f32x4 o0 = v[h][0] * rstd * gg[h][0] + bb[h][0], o1 = v[h][1] * rstd * gg[h][1] + bb[h][1]; const size_t o = (size_t)(m + r) * D + 512 * h + 8 * lane;
                if (l == 1) { *(f32x4*)(p.out + o) = o0; *(f32x4*)(p.out + o + 4) = o1; }
                else { v4u w; w.x = pk2(o0.x, o0.y); w.y = pk2(o0.z, o0.w); w.z = pk2(o1.x, o1.y); w.w = pk2(o1.z, o1.w); *(v4u*)(XO + o) = w; } }
        }
        if (!more) break;
        m = mn;
    }
}

__global__ void __launch_bounds__(NWAVES * 64, 2) mk_fwd(Params p) {
    extern __shared__ __attribute__((aligned(16))) unsigned char lds_raw[];
    LAS unsigned char* lds = (LAS unsigned char*)lds_raw;
    LAS unsigned char* ext = lds + EXT_OFF;
    const int tid = threadIdx.x, wave = __builtin_amdgcn_readfirstlane(tid >> 6); int lane = tid & 63;
int ftid = tid;
#define FRESH_LANE() do { asm volatile("" : "+v"(lane)); ftid = tid; asm volatile("" : "+v"(ftid)); } while (0)
    const int G = gridDim.x, bx = blockIdx.x, vcu = (G % 8 == 0) ? (bx % 8) * (G / 8) + bx / 8 : bx;
    const int gw = bx * NWAVES + wave, NGW = G * NWAVES;
    gu32* ctl = (gu32*)(p.ws + WS_CTL);
    for (int u = tid; u < (LDS_BYTES - EXT_OFF) / 4; u += NWAVES * 64) ((LAS unsigned*)ext)[u] = 0u;
    __syncthreads();
    const int lo = p.ph_lo, hi = p.ph_hi;
    XcdBarrier bar; bar.bar = (unsigned*)ctl + CW_BAR; bar.x = 0; bar.st = nullptr;
    if (hi - lo > 1) bar = xcd_barrier_post((unsigned*)ctl + CW_BAR, (volatile LAS unsigned*)(ext + EXT_MISC) + 8);
#ifndef MK_ONLY
#define MK_ONLY -1
#endif
#define PH_ON(j) (MK_ONLY < 0 || MK_ONLY == (j))
#define IN(k) (lo <= (k) && (k) < hi)
#ifndef PROBE_PH
#define PROBE_PH -1
#endif
    unsigned long long pr_acc = 0ull, pr_t0 = 0ull;
#define PR_BEGIN(j) do { if (PROBE_PH == (j)) pr_t0 = __builtin_amdgcn_s_memrealtime(); } while (0)
#define PR_END(j) do { if (PROBE_PH == (j)) pr_acc += __builtin_amdgcn_s_memrealtime() - pr_t0; } while (0)
#define SEAM(k) do { if (IN(k) && IN((k) + 1)) xcd_barrier(bar); } while (0)
    bf16* XH0 = (bf16*)(p.ws + WS_XH0); bf16* XH1 = (bf16*)(p.ws + WS_XH1);

    PR_BEGIN(8);
    if (PH_ON(0) && IN(0)) {
        FRESH_LANE();
        LAS float* scr = (LAS float*)(lds + wave * TSCR_BYTES);
        phase_cvt_small(p, scr, gw, NGW, lane);
        __syncthreads();
        phase_cvt_moe(p, 0, lds, bx, G, ftid);
        phase_ln0_p(p, gw, NGW, lane);
    }
    SEAM(0);
    PR_END(8);
#define MK_LAYER(l) do { \
        const int b = 1 + 8 * l; \
        unsigned char* sw = p.ws + WS_SMALLW + (size_t)l * SW_LAYER; \
        const unsigned* cnt = (const unsigned*)(p.ws + WS_CTL) + CW_CNT + 64 * l; \
        PR_BEGIN(0); \
        if (PH_ON(1) && IN(b)) { \
            FRESH_LANE(); \
            *(LAS f32x4*)(ext + EXT_BIAS + 16 * ftid) = *(const f32x4*)((const float*)(sw + SW_BIN) + 4 * ftid); \
            __syncthreads(); \
            { pg8::DenseOrder S; S.init(XH0, (const bf16*)(sw + SW_WIN), NTOK, DIN, D, G, bx); \
              pg8::EpiPairZ E{(bf16*)(p.ws + WS_Z), (const LAS float*)(ext + EXT_BIAS)}; \
              pg8::gemm_phase(lds, D, S, E); } \
            { pg8::DenseOrder S; S.init((const bf16*)(p.ws + WS_PB) + (size_t)l * NTOK * DPLE, (const bf16*)(sw + SW_WP), NTOK, D, DPLE, G, bx); \
              pg8::EpiPlain E{(bf16*)(p.ws + WS_PP), D}; \
              pg8::gemm_phase(lds, DPLE, S, E); } \
        } \
        SEAM(b); \
        PR_END(0); \
        PR_BEGIN(1); \
        if (PH_ON(2) && IN(b + 1)) { \
            FRESH_LANE(); \
            phase_mixer(p, l, lds, vcu, G, wave, lane); \
            if (l == 1) { phase_cvt_moe(p, 1, lds, bx, G, ftid); } \
        } \
        SEAM(b + 1); \
        PR_END(1); \
        PR_BEGIN(2); \
        if (PH_ON(3) && IN(b + 2)) { \
            pg8::DenseOrder S; S.init((const bf16*)(p.ws + WS_A2), (const bf16*)(sw + SW_WO), NTOK, D, D, G, bx); \
            pg8::EpiRes E{XH0, XH1}; \
            pg8::gemm_phase(lds, D, S, E); \
        } \
        SEAM(b + 2); \
        PR_END(2); \
        const size_t dofs = 0; \
        PR_BEGIN(3); \
        if (PH_ON(4) && IN(b + 3)) { FRESH_LANE(); phase_route(p, l, lds, bx, wave, lane, ftid, dofs); } \
        SEAM(b + 3); \
        PR_END(3); \
        PR_BEGIN(4); \
        if (PH_ON(4) && IN(b + 4)) { FRESH_LANE(); phase_scatter(p, l, lds, bx, G, ftid, dofs, l + 2 * p.pad); } \
        SEAM(b + 4); \
        PR_END(4); \
        PR_BEGIN(5); \
        if (PH_ON(5) && IN(b + 5)) { \
            FRESH_LANE(); \
            const int T4 = moe_tables(cnt, ext, ftid); \
            pg8::MoeOrder<true> S{(const LAS int*)(ext + EXT_TB), (const LAS int*)(ext + EXT_CT), (const LAS int*)(ext + EXT_T2E), T4, G, vcu, D / 2, (const char*)(p.ws + WS_XQ), (const char*)(p.ws + WS_WUP), (size_t)1024 * 1024, (const int*)(p.ws + WS_LIST)}; \
            pg8::EpiUp E{p.ws + WS_H}; \
            pg8::gemm_phase(lds, D / 2, S, E); \
            { const int rem = (T4 & 255), nl = 256 - rem, j = vcu - rem; \
              pg8::ListOrder SG{(j >= 0) ? 1 : 0, j, -1, 512, D / 2, (const char*)(p.ws + WS_XQ), (const char*)(sw + SW_WG)}; \
              pg8::EpiGate EG{(bf16*)(p.ws + WS_PP), p.in[I_BG] + (size_t)l * D}; \
              (void)nl; pg8::gemm_phase(lds, D / 2, SG, EG); } \
        } \
        SEAM(b + 5); \
        PR_END(5); \
        PR_BEGIN(6); \
        if (PH_ON(6) && IN(b + 6)) { \
            FRESH_LANE(); \
            const int T4 = moe_tables(cnt, ext, ftid); \
            pg8::MoeOrder<false> S{(const LAS int*)(ext + EXT_TB), (const LAS int*)(ext + EXT_CT), (const LAS int*)(ext + EXT_T2E), T4, G, vcu, DEXP / 2, (const char*)(p.ws + WS_H), (const char*)(p.ws + WS_WDN), (size_t)1024 * 512, (const int*)(p.ws + WS_LIST)}; \
            pg8::EpiDown E{p.ws + WS_YS}; \
            pg8::gemm_phase(lds, DEXP / 2, S, E); \
            { const int rem = (T4 & 255), nl = 256 - rem, j = vcu - rem; \
              pg8::ListOrder SG{(j >= 0) ? 1 : 0, nl + j, 2 * nl + vcu, 512, D / 2, (const char*)(p.ws + WS_XQ), (const char*)(sw + SW_WG)}; \
              pg8::EpiGate EG{(bf16*)(p.ws + WS_PP), p.in[I_BG] + (size_t)l * D}; \
              pg8::gemm_phase(lds, D / 2, SG, EG); } \
        } \
        SEAM(b + 6); \
        PR_END(6); \
        PR_BEGIN(7); \
        if (PH_ON(7) && IN(b + 7)) { FRESH_LANE(); (void)moe_tables(cnt, ext, ftid); phase_ln2(p, l, (const LAS int*)(ext + EXT_TB), gw, NGW, lane); } \
        SEAM(b + 7); \
        PR_END(7); \
    } while (0)
    MK_LAYER(0);
    MK_LAYER(1);
#undef MK_LAYER
    if (PROBE_PH >= 0 && bx == 0) { const unsigned long long t0 = __builtin_amdgcn_s_memrealtime(); while (__builtin_amdgcn_s_memrealtime() - t0 < 8ull * pr_acc) __builtin_amdgcn_s_sleep(8); }
#undef IN
#undef SEAM
}
#ifndef MK_FUSED
#define MK_FUSED 1
#endif
#ifndef MK_DUP
#define MK_DUP 0x0
#endif
extern "C" void kernel_launch(void* const* d_in, const int* in_sizes, int n_in, void* d_out, int out_size, void* d_ws, size_t ws_size, hipStream_t stream) {
    static int grid = 0;
    if (grid == 0) {
        if (n_in != 24 || in_sizes[0] != NTOK * D || out_size != NTOK * D || ws_size < WS_END) {
            fprintf(stderr, "kernel_launch: unexpected shapes (n_in %d, in0 %d, out %d, ws %zu < %zu); nothing launched\n", n_in, n_in > 0 ? in_sizes[0] : -1, out_size, ws_size, (size_t)WS_END); grid = -1; return; }
        int dev = 0, cus = 0, per_cu = 0;
        if (hipGetDevice(&dev) != hipSuccess || hipDeviceGetAttribute(&cus, hipDeviceAttributeMultiprocessorCount, dev) != hipSuccess) { grid = -1; return; }
        if (hipFuncSetAttribute((const void*)mk_fwd, hipFuncAttributeMaxDynamicSharedMemorySize, LDS_BYTES) != hipSuccess) { fprintf(stderr, "kernel_launch: hipFuncSetAttribute failed\n"); grid = -1; return; }
        if (hipOccupancyMaxActiveBlocksPerMultiprocessor(&per_cu, (const void*)mk_fwd, NWAVES * 64, LDS_BYTES) != hipSuccess || per_cu < 1) { fprintf(stderr, "kernel_launch: occupancy query says %d blocks per CU\n", per_cu); }
        (void)hipGetLastError();
        grid = cus;
        if (grid != 256) { fprintf(stderr, "kernel_launch: built for 256 CUs, device has %d; nothing launched\n", cus); grid = -1; return; }
    }
    if (grid < 0) return;
    (void)hipMemsetAsync((char*)d_ws + WS_CTL, 0, CTL_BYTES, stream);
    Params p{};
    for (int i = 0; i < 24; ++i) p.in[i] = (const float*)d_in[i];
    p.out = (float*)d_out; p.ws = (unsigned char*)d_ws; p.layer = 0; p.ph_lo = 0; p.ph_hi = 0; p.pad = 0;
#if MK_FUSED
    p.ph_lo = 0; p.ph_hi = N_PHASES;
    hipLaunchKernelGGL(mk_fwd, dim3(grid), dim3(NWAVES * 64), LDS_BYTES, stream, p);
#else
    for (int ph = 0; ph < N_PHASES; ++ph) {
        const int k = ph == 0 ? -1 : (ph - 1) % 8;
        p.ph_lo = ph; p.ph_hi = ph + 1; hipLaunchKernelGGL(mk_fwd, dim3(grid), dim3(NWAVES * 64), LDS_BYTES, stream, p);
        if ((MK_DUP >> ph) & 1) { if (k == 2 || k == 3 || k == 4 || k == 7) p.pad = 1; hipLaunchKernelGGL(mk_fwd, dim3(grid), dim3(NWAVES * 64), LDS_BYTES, stream, p); p.pad = 0; }
    }
#endif
}
```

```cpp
#include <hip/hip_runtime.h>
#include <stdio.h>

#define LAS __attribute__((address_space(3)))
typedef unsigned short bf16;
typedef short bf16x8 __attribute__((ext_vector_type(8)));
typedef float f32x4 __attribute__((ext_vector_type(4)));
typedef unsigned v4u __attribute__((ext_vector_type(4)));
typedef unsigned v2u __attribute__((ext_vector_type(2)));

constexpr int NTOK = 32768, SEQ = 8192, D = 1024, DZ = 1536, DIN = 2048, DPLE = 256, DEXP = 512, NEXP = 32, LCAP = 32768;
constexpr int MAXTILES = 288;
constexpr float ALPHA = 1.41421356237309515f;
constexpr float LN_EPS = 1e-5f;
constexpr float W8_SCALE = 32.f, H8_SCALE = 8.f, Y8_SCALE = 8.f;

constexpr size_t MiB = 1u << 20;
constexpr size_t WS_CTL = 0, CTL_BYTES = 1 * MiB;
constexpr size_t WS_SMALLW = 4 * MiB;
constexpr size_t SW_LAYER = 10 * MiB, SW_WIN = 0, SW_WO = 4 * MiB, SW_WG = 6 * MiB, SW_WP = 8 * MiB, SW_PW = 8 * MiB + 512 * 1024, SW_BIN = 8 * MiB + 768 * 1024, SW_WR = 9 * MiB;
constexpr size_t WS_WUP = 24 * MiB, WS_WDN = 88 * MiB;
constexpr size_t WS_XH0 = 120 * MiB, WS_XH1 = 184 * MiB;
constexpr size_t WS_PB = 248 * MiB;
constexpr size_t WS_PP = 280 * MiB;
constexpr size_t WS_LIST = 344 * MiB, WS_LW = 348 * MiB, WS_TOKREC = 352 * MiB;
constexpr size_t WS_TOKW = 352 * MiB + 512 * 1024, WS_HIST = 353 * MiB;
constexpr size_t WS_H = 354 * MiB, WS_YS = 426 * MiB;
constexpr size_t WS_A2 = WS_H, WS_Z = WS_YS;
constexpr size_t WS_XQ = 570 * MiB;
constexpr size_t WS_END = 602 * MiB;
constexpr int CW_CNT = 1024;

__device__ __forceinline__ unsigned f2bf(float f) { unsigned u = __builtin_bit_cast(unsigned, f); return (u + 0x7fffu + ((u >> 16) & 1u)) >> 16; }
__device__ __forceinline__ unsigned pk2(float lo, float hi) { return f2bf(lo) | (f2bf(hi) << 16); }
__device__ __forceinline__ float sat8(float x) { return __builtin_amdgcn_fmed3f(x, -440.f, 440.f); }
__device__ __forceinline__ unsigned pk4_fp8(float a, float b, float c, float d) { int w = 0; w = __builtin_amdgcn_cvt_pk_fp8_f32(a, b, w, false); w = __builtin_amdgcn_cvt_pk_fp8_f32(c, d, w, true); return (unsigned)w; }
typedef float f32x2_t __attribute__((ext_vector_type(2)));
__device__ __forceinline__ void unpack8_fp8(const v2u x, f32x4& lo, f32x4& hi) {
    const f32x2_t a = __builtin_amdgcn_cvt_pk_f32_fp8((int)x.x, false), b = __builtin_amdgcn_cvt_pk_f32_fp8((int)x.x, true), c = __builtin_amdgcn_cvt_pk_f32_fp8((int)x.y, false), d = __builtin_amdgcn_cvt_pk_f32_fp8((int)x.y, true);
    lo[0] = a[0]; lo[1] = a[1]; lo[2] = b[0]; lo[3] = b[1]; hi[0] = c[0]; hi[1] = c[1]; hi[2] = d[0]; hi[3] = d[1]; }
__device__ __forceinline__ float bf2f(bf16 b) { return __builtin_bit_cast(float, ((unsigned)b) << 16); }
__device__ __forceinline__ float wave_sum(float v) {
#pragma unroll
    for (int o = 1; o < 64; o <<= 1) v += __shfl_xor(v, o);
    return v;
}
#define LDS_WAIT() asm volatile("s_waitcnt lgkmcnt(0)" ::: "memory")

struct Params {
    const float* in[24];
    float* out;
    unsigned char* ws;
    int layer, ph_lo, ph_hi, pad;
};
enum { I_X = 0, I_P, I_LN0G, I_LN0B, I_WIN, I_BIN, I_CONVW, I_POOLW, I_PSCALE, I_WO, I_LN1G, I_LN1B, I_WRG, I_BRG, I_WRE, I_BRE, I_W1, I_W3, I_W2, I_WG, I_BG, I_WP, I_LN2G, I_LN2B };

constexpr int TSCR_BYTES = 64 * 65 * 4;
struct TItem { const float* src; bf16* dst; int ldw, ldt, f8; };
__device__ __forceinline__ int pair_row(int c) { return 256 * (c >> 7) + (c & 127); }
__device__ __forceinline__ void titem_load(const TItem& t, f32x4 (&v)[16], int lane) {
    const int lk = lane >> 4, ln = 4 * (lane & 15);
#pragma unroll
    for (int i = 0; i < 16; ++i) v[i] = *(const f32x4*)(t.src + (size_t)(4 * i + lk) * t.ldw + ln);
}
__device__ __forceinline__ void titem_to_lds(const f32x4 (&v)[16], LAS float* scr, int lane) {
    const int lk = lane >> 4, ln = 4 * (lane & 15);
#pragma unroll
    for (int i = 0; i < 16; ++i) { LAS float* d = scr + (4 * i + lk) * 65 + ln; d[0] = v[i].x; d[1] = v[i].y; d[2] = v[i].z; d[3] = v[i].w; }
}
__device__ __forceinline__ unsigned cvt2bf(float lo, float hi) { unsigned r; asm volatile("v_cvt_pk_bf16_f32 %0, %1, %2" : "=v"(r) : "v"(lo), "v"(hi)); return r; }
__device__ __forceinline__ void titem_finish(const TItem& t, const LAS float* scr, int lane) {
    const int c = lane & 7;
#pragma unroll
    for (int j = 0; j < 8; ++j) { const int n = (lane >> 3) + 8 * j; const LAS float* s = scr + (8 * c) * 65 + n;
        v4u o; o.x = cvt2bf(s[0 * 65], s[1 * 65]); o.y = cvt2bf(s[2 * 65], s[3 * 65]); o.z = cvt2bf(s[4 * 65], s[5 * 65]); o.w = cvt2bf(s[6 * 65], s[7 * 65]);
        *(v4u*)(t.dst + (size_t)n * t.ldt + 8 * c) = o; }
}
__device__ __forceinline__ void titem_finish8(const TItem& t, const LAS float* scr, int lane) {
    const int c = lane & 3; unsigned char* d8 = (unsigned char*)t.dst;
#pragma unroll
    for (int j = 0; j < 4; ++j) { const int n = (lane >> 2) + 16 * j; const LAS float* s = scr + (16 * c) * 65 + n; v4u o;
        o.x = pk4_fp8(s[0 * 65] * W8_SCALE, s[1 * 65] * W8_SCALE, s[2 * 65] * W8_SCALE, s[3 * 65] * W8_SCALE); o.y = pk4_fp8(s[4 * 65] * W8_SCALE, s[5 * 65] * W8_SCALE, s[6 * 65] * W8_SCALE, s[7 * 65] * W8_SCALE);
        o.z = pk4_fp8(s[8 * 65] * W8_SCALE, s[9 * 65] * W8_SCALE, s[10 * 65] * W8_SCALE, s[11 * 65] * W8_SCALE); o.w = pk4_fp8(s[12 * 65] * W8_SCALE, s[13 * 65] * W8_SCALE, s[14 * 65] * W8_SCALE, s[15 * 65] * W8_SCALE);
        *(v4u*)(d8 + (size_t)n * t.ldt + 16 * c) = o; }
}
template <class Get> __device__ __forceinline__ void cvt_loop(const Get& get, int nitems, LAS float* scr, int gw, int NGW, int lane) {
    int it = gw; if (it >= nitems) return;
    TItem cur = get(it), nxt = cur; f32x4 v[16];
    titem_load(cur, v, lane);
    for (;;) {
        titem_to_lds(v, scr, lane);
        LDS_WAIT(); asm volatile("" ::: "memory");
        const int nit = it + NGW; const bool more = nit < nitems;
        if (more) { nxt = get(nit); titem_load(nxt, v, lane); }
        if (cur.f8) titem_finish8(cur, scr, lane); else titem_finish(cur, scr, lane);
        LDS_WAIT(); asm volatile("" ::: "memory");
        if (!more) break;
        cur = nxt; it = nit;
    }
}
struct GetSmall { const Params* p;
    __device__ __forceinline__ TItem operator()(int it) const {
        constexpr int I_IN = 16 * 32, I_O = 16 * 16, I_G = 16 * 16, I_PJ = 4 * 16, I_PL = 4 * 4, PER = I_IN + I_O + I_G + I_PJ + I_PL;
        const int l = it / PER; int r = it % PER; unsigned char* sw = p->ws + WS_SMALLW + (size_t)l * SW_LAYER;
        if (r < I_IN) { const int kb = r / 32, nb = r % 32, n0 = 64 * nb; const int reg = n0 >> 9, cc = n0 & 511;
            const int drow = reg == 0 ? pair_row(cc) : reg == 1 ? 1024 + cc : reg == 2 ? pair_row(cc) + 128 : 1536 + cc;
            return TItem{p->in[I_WIN] + (size_t)l * D * DIN + (size_t)(64 * kb) * DIN + n0, (bf16*)(sw + SW_WIN) + (size_t)drow * D + 64 * kb, DIN, D, 0}; }
        r -= I_IN;
        if (r < I_O) { const int kb = r / 16, nb = r % 16; return TItem{p->in[I_WO] + (size_t)l * D * D + (size_t)(64 * kb) * D + 64 * nb, (bf16*)(sw + SW_WO) + (size_t)(64 * nb) * D + 64 * kb, D, D, 0}; }
        r -= I_O;
        if (r < I_G) { const int kb = r / 16, nb = r % 16; return TItem{p->in[I_WG] + (size_t)l * D * D + (size_t)(64 * kb) * D + 64 * nb, (bf16*)(sw + SW_WG + (size_t)(64 * nb) * D + 64 * kb), D, D, 1}; }
        r -= I_G;
        if (r < I_PJ) { const int kb = r / 16, nb = r % 16; return TItem{p->in[I_WP] + (size_t)l * DPLE * D + (size_t)(64 * kb) * D + 64 * nb, (bf16*)(sw + SW_WP) + (size_t)(64 * nb) * DPLE + 64 * kb, D, DPLE, 0}; }
        r -= I_PJ;
        const int g = r / 4, q = r % 4, kb = q / 2, nb = q % 2;
        return TItem{p->in[I_POOLW] + ((size_t)l * 4 + g) * 128 * 128 + (size_t)(64 * kb) * 128 + 64 * nb, (bf16*)(sw + SW_PW) + (size_t)g * 128 * 128 + (size_t)(64 * nb) * 128 + 64 * kb, 128, 128, 0};
    } };
__device__ __forceinline__ void phase_cvt_small(const Params& p, LAS float* scr, int gw, int NGW, int lane) {
    constexpr int PER = 16 * 32 + 16 * 16 + 16 * 16 + 4 * 16 + 4 * 4;
    cvt_loop(GetSmall{&p}, 2 * PER, scr, gw, NGW, lane);
    for (int i = gw * 64 + lane; i < 2 * DIN; i += NGW * 64) {
        const int l = i / DIN, n = i % DIN; int src;
        if (n < 1024) { const int t = n >> 8, h = (n >> 7) & 1, j = n & 127; src = (h ? 1024 : 0) + 128 * t + j; } else if (n < 1536) src = n - 512; else src = n;
        ((float*)(p.ws + WS_SMALLW + (size_t)l * SW_LAYER + SW_BIN))[n] = p.in[I_BIN][(size_t)l * DIN + src];
    }
}
struct WTile { const float* src; unsigned char* dst; int ldw, ldt, kind; };
__device__ __forceinline__ WTile moe_tile(const Params& p, int l, int t, int& n0) {
    unsigned char* WUP = p.ws + WS_WUP; unsigned char* WDN = p.ws + WS_WDN;
    const int e = t / 48; int r = t % 48; const size_t eo = ((size_t)l * NEXP + e);
    if (r < 32) { const int m3 = r >> 4, q = r & 15, kb = q >> 2, nb = q & 3; n0 = 128 * nb;
        return WTile{(m3 ? p.in[I_W3] : p.in[I_W1]) + eo * D * DEXP + (size_t)(256 * kb) * DEXP + 128 * nb, WUP + (size_t)e * 1024 * 1024 + 256 * kb, DEXP, D, m3}; }
    r -= 32; { const int kb = r >> 3, nb = r & 7; n0 = 128 * nb;
        return WTile{p.in[I_W2] + eo * DEXP * D + (size_t)(256 * kb) * D + 128 * nb, WDN + (size_t)e * 1024 * 512 + 256 * kb, D, DEXP, 2}; }
}
__device__ __forceinline__ void wtile_load(const WTile& w, f32x4 (&v)[16], int tid) {
#pragma unroll
    for (int i = 0; i < 16; ++i) { const int idx = tid + 512 * i; v[i] = *(const f32x4*)(w.src + (size_t)(idx >> 5) * w.ldw + 4 * (idx & 31)); }
}
__device__ __forceinline__ void phase_cvt_moe(const Params& p, int l, LAS unsigned char* lds, int bx, int G, int tid) {
    LAS float* scr = (LAS float*)lds;
    int t = bx; if (t >= NEXP * 48) return;
    int n0c = 0, n0n = 0;
    WTile cur = moe_tile(p, l, t, n0c), nxt = cur; f32x4 v[16];
    wtile_load(cur, v, tid);
    const int c_lo = tid & 7, n_lo = (tid >> 3) & 7, wv = tid >> 6;
    for (;;) {
#pragma unroll
        for (int i = 0; i < 16; ++i) { const int idx = tid + 512 * i; LAS float* d = scr + (idx >> 5) * 129 + 4 * (idx & 31); d[0] = v[i].x; d[1] = v[i].y; d[2] = v[i].z; d[3] = v[i].w; }
        __syncthreads();
        const int tn = t + G; const bool more = tn < NEXP * 48;
        if (more) { nxt = moe_tile(p, l, tn, n0n); wtile_load(nxt, v, tid); }
#pragma unroll
        for (int j = 0; j < 4; ++j) { const int n = n_lo + 8 * (wv + 8 * (j & 1)), c = c_lo + 8 * (j >> 1); const LAS float* s = scr + (16 * c) * 129 + n; v4u o;
            o.x = pk4_fp8(s[0 * 129] * W8_SCALE, s[1 * 129] * W8_SCALE, s[2 * 129] * W8_SCALE, s[3 * 129] * W8_SCALE); o.y = pk4_fp8(s[4 * 129] * W8_SCALE, s[5 * 129] * W8_SCALE, s[6 * 129] * W8_SCALE, s[7 * 129] * W8_SCALE);
            o.z = pk4_fp8(s[8 * 129] * W8_SCALE, s[9 * 129] * W8_SCALE, s[10 * 129] * W8_SCALE, s[11 * 129] * W8_SCALE); o.w = pk4_fp8(s[12 * 129] * W8_SCALE, s[13 * 129] * W8_SCALE, s[14 * 129] * W8_SCALE, s[15 * 129] * W8_SCALE);
            const int nn = n0c + n, drow = cur.kind == 2 ? nn : pair_row(nn) + (cur.kind == 1 ? 128 : 0);
            *(v4u*)(cur.dst + (size_t)drow * cur.ldt + 16 * c) = o; }
        __syncthreads();
        if (!more) break;
        cur = nxt; t = tn; n0c = n0n;
    }
}
__device__ __forceinline__ void ln_row2(const float* xrow, const float* g, const float* b, bf16* hrow, int lane) {
    const f32x4* xr = (const f32x4*)xrow + lane;
    f32x4 v[2][4]; float s[2] = {0.f, 0.f};
#pragma unroll
    for (int q = 0; q < 2; ++q)
#pragma unroll
        for (int j = 0; j < 4; ++j) v[q][j] = xr[q * (D / 4) + 64 * j];
#pragma unroll
    for (int q = 0; q < 2; ++q) {
#pragma unroll
        for (int j = 0; j < 4; ++j) s[q] += (v[q][j].x + v[q][j].y) + (v[q][j].z + v[q][j].w);
        const float mean = wave_sum(s[q]) * (1.f / D); float s2 = 0.f;
#pragma unroll
        for (int j = 0; j < 4; ++j) { v[q][j] = v[q][j] - mean; s2 += (v[q][j].x * v[q][j].x + v[q][j].y * v[q][j].y) + (v[q][j].z * v[q][j].z + v[q][j].w * v[q][j].w); }
        const float rstd = 1.f / sqrtf(wave_sum(s2) * (1.f / D) + LN_EPS);
#pragma unroll
        for (int j = 0; j < 4; ++j) { const f32x4 gg = ((const f32x4*)g)[lane + 64 * j], bb = ((const f32x4*)b)[lane + 64 * j];
            const f32x4 o = v[q][j] * rstd * gg + bb;
            v2u w; w.x = pk2(o.x, o.y); w.y = pk2(o.z, o.w); ((v2u*)hrow)[q * (D / 4) + lane + 64 * j] = w; } }
}
__device__ __forceinline__ void phase_ln0_p(const Params& p, int gw, int NGW, int lane) {
    bf16* XH0 = (bf16*)(p.ws + WS_XH0);
    for (int m = 2 * gw; m < NTOK; m += 2 * NGW) ln_row2(p.in[I_X] + (size_t)m * D, p.in[I_LN0G], p.in[I_LN0B], XH0 + (size_t)m * D, lane);
    bf16* PB = (bf16*)(p.ws + WS_PB);
    for (size_t i0 = (size_t)gw * 256; i0 < (size_t)2 * NTOK * DPLE / 8; i0 += (size_t)NGW * 256) {
        f32x4 a[4], b[4];
#pragma unroll
        for (int q = 0; q < 4; ++q) { const size_t i = i0 + 64 * q + lane; a[q] = ((const f32x4*)p.in[I_P])[2 * i]; b[q] = ((const f32x4*)p.in[I_P])[2 * i + 1]; }
#pragma unroll
        for (int q = 0; q < 4; ++q) { const size_t i = i0 + 64 * q + lane; v4u o; o.x = pk2(a[q].x, a[q].y); o.y = pk2(a[q].z, a[q].w); o.z = pk2(b[q].x, b[q].y); o.w = pk2(b[q].z, b[q].w); ((v4u*)PB)[i] = o; } }
    for (int i = gw * 64 + lane; i < 2 * 48 * D; i += NGW * 64) {
        const int l = i / (48 * D), n = (i / D) % 48, k = i % D; float w = 0.f;
        if (n < 4) w = p.in[I_WRG][((size_t)l * D + k) * 4 + n]; else if (n < 36) w = p.in[I_WRE][(((size_t)l * 4 + ((n - 4) >> 3)) * D + k) * 8 + ((n - 4) & 7)];
        const unsigned h = f2bf(w); const float r = w - __builtin_bit_cast(float, h << 16);
        bf16* WR = (bf16*)(p.ws + WS_SMALLW + (size_t)l * SW_LAYER + SW_WR); WR[n * D + k] = (bf16)h; WR[48 * D + n * D + k] = (bf16)f2bf(r); }
}

namespace pg8 {
typedef unsigned u32x4 __attribute__((ext_vector_type(4)));
typedef int v4i32 __attribute__((ext_vector_type(4)));
typedef int v8i32 __attribute__((ext_vector_type(8)));
constexpr int BM = 256, BK = 64, HALF = 128, HTB = HALF * BK * 2, STAGE_BYTES = 8 * HTB, NXCD = 8, WGM = 8;
__device__ __forceinline__ int lds_byte(int r, int c) { const int st = (r >> 4) * 2 + (c >> 5), rr = r & 15, cc = c & 31, ob = rr * 64 + cc * 2; return st * 1024 + (ob ^ (((ob >> 9) & 1) << 5)); }
__device__ __forceinline__ void stage_rc(int b, int& R, int& C) { const int st = b / 1024, sb = b % 1024, swz = sb ^ (((sb >> 9) & 1) << 5); R = (st >> 1) * 16 + swz / 64; C = (st & 1) * 32 + (swz % 64) / 2; }
__device__ __forceinline__ int perm32(int rho) { const int n = rho >> 4, i = rho & 15; return 8 * (i >> 2) + 4 * n + (i & 3); }
__device__ __forceinline__ unsigned cvt_pk_bf16(float lo, float hi) { unsigned r; asm volatile("v_cvt_pk_bf16_f32 %0, %1, %2" : "=v"(r) : "v"(lo), "v"(hi)); return r; }

struct Unit { int pm, pn, e, r0, ce; };

struct DenseOrder {
    static constexpr bool GATHER = false;
    int nM, nN, nwg, G, c, K; const char* A; const char* Bt;
    __device__ __forceinline__ void init(const bf16* A_, const bf16* Bt_, int M, int N, int K_, int G_, int c_) { A = (const char*)A_; Bt = (const char*)Bt_; nM = M / BM; nN = N / BM; nwg = nM * nN; G = G_; c = c_; K = K_; }
    __device__ __forceinline__ bool next(int i, Unit& u) const {
        const long L = (long)i * G + c; if (L >= nwg) return false;
        int wgid = (int)L; { const int q = nwg / NXCD, r = nwg % NXCD, xcd = wgid % NXCD, off = wgid / NXCD; wgid = (xcd < r ? xcd * (q + 1) : r * (q + 1) + (xcd - r) * q) + off; }
        const int nig = WGM * nN, gid = wgid / nig, fm = gid * WGM, gsz = (nM - fm) < WGM ? (nM - fm) : WGM;
        u.pm = fm + ((wgid % nig) % gsz); u.pn = (wgid % nig) / gsz; u.e = 0; u.r0 = 0; u.ce = 0; return true;
    }
    __device__ __forceinline__ const char* a_base(const Unit& u) const { return A + (size_t)u.pm * BM * K * 2; }
    __device__ __forceinline__ const char* b_base(const Unit& u) const { return Bt + (size_t)u.pn * BM * K * 2; }
    __device__ __forceinline__ void a_offs(const Unit&, unsigned (&v)[2][2], int) const {}
};
struct ListOrder {
    static constexpr bool GATHER = false;
    int na, ua, ub0, lim, K; const char* A; const char* Bt;
    __device__ __forceinline__ bool next(int i, Unit& u) const {
        int id; if (i < na) id = ua; else { id = ub0 + 256 * (i - na); if (ub0 < 0 || id >= lim) return false; }
        u.pm = id >> 2; u.pn = id & 3; u.e = 0; u.r0 = 0; u.ce = 0; return true;
    }
    __device__ __forceinline__ const char* a_base(const Unit& u) const { return A + (size_t)u.pm * BM * K * 2; }
    __device__ __forceinline__ const char* b_base(const Unit& u) const { return Bt + (size_t)u.pn * BM * K * 2; }
    __device__ __forceinline__ void a_offs(const Unit&, unsigned (&v)[2][2], int) const {}
};
template <bool GATHER_> struct MoeOrder {
    static constexpr bool GATHER = GATHER_;
    const LAS int* tb; const LAS int* ct; const LAS int* t2e;
    int T4, G, c, K; const char* A; const char* W; size_t wstride; const int* list;
    __device__ __forceinline__ bool next(int i, Unit& u) const {
        const int L = i * G + c; if (L >= T4) return false;
        const int mt = L >> 2, e = t2e[mt];
        u.pm = mt; u.pn = L & 3; u.e = e; u.r0 = 256 * (mt - tb[e]); u.ce = ct[e]; return true;
    }
    __device__ __forceinline__ const char* a_base(const Unit& u) const { return GATHER ? A : A + (size_t)u.pm * BM * K * 2; }
    __device__ __forceinline__ const char* b_base(const Unit& u) const { return W + (size_t)u.e * wstride + (size_t)u.pn * BM * K * 2; }
    __device__ __forceinline__ void a_offs(const Unit& u, unsigned (&v)[2][2], int tid) const {
#pragma unroll
        for (int i = 0; i < 2; ++i) { int R, C; stage_rc(tid * 16 + i * 8192, R, C);
#pragma unroll
            for (int h = 0; h < 2; ++h) { const int rank = u.r0 + HALF * h + R; const int lv = list[(size_t)u.e * LCAP + rank];
                const int tok = rank < u.ce ? (lv >> 1) : 0;
                v[h][i] = (unsigned)(tok * K + C) * 2u; } } }
};

#define EPI_ARGS const f32x4 (&acc)[2][2][4][2], const Unit& u, int wr, int wc, int fr, int fq
__device__ __forceinline__ u32x4 pack8(const f32x4 v0, const f32x4 v1) { u32x4 w; w.x = cvt_pk_bf16(v0[0], v0[1]); w.y = cvt_pk_bf16(v0[2], v0[3]); w.z = cvt_pk_bf16(v1[0], v1[1]); w.w = cvt_pk_bf16(v1[2], v1[3]); return w; }
__device__ __forceinline__ void unpack4x2(const v4u x, f32x4& lo, f32x4& hi) {
    lo[0] = __uint_as_float(x.x << 16); lo[1] = __uint_as_float(x.x & 0xffff0000u); lo[2] = __uint_as_float(x.y << 16); lo[3] = __uint_as_float(x.y & 0xffff0000u);
    hi[0] = __uint_as_float(x.z << 16); hi[1] = __uint_as_float(x.z & 0xffff0000u); hi[2] = __uint_as_float(x.w << 16); hi[3] = __uint_as_float(x.w & 0xffff0000u); }
struct EpiPlain {
    static constexpr bool PERM = true, AFTER_DRAIN = false, FP8 = false;
    bf16* O; int ldc;
    __device__ __forceinline__ void operator()(EPI_ARGS) const {
        const int row0 = u.pm * BM + wr * 64 + fr, col0 = u.pn * BM + wc * 32 + 8 * fq;
#pragma unroll
        for (int ai = 0; ai < 2; ++ai)
#pragma unroll
            for (int m = 0; m < 4; ++m) { bf16* rowp = O + (size_t)(row0 + ai * HALF + m * 16) * ldc + col0;
#pragma unroll
                for (int bj = 0; bj < 2; ++bj) *(u32x4*)(rowp + bj * HALF) = pack8(acc[ai][bj][m][0], acc[ai][bj][m][1]); }
    }
};
struct EpiPairZ {
    static constexpr bool PERM = true, AFTER_DRAIN = false, FP8 = false;
    bf16* Z; const LAS float* bias;
    __device__ __forceinline__ void operator()(EPI_ARGS) const {
        const int row0 = u.pm * BM + wr * 64 + fr, bcol0 = u.pn * BM + wc * 32 + 8 * fq;
        f32x4 bv[2][2];
#pragma unroll
        for (int bj = 0; bj < 2; ++bj)
#pragma unroll
            for (int n = 0; n < 2; ++n) bv[bj][n] = *(const LAS f32x4*)(bias + bcol0 + bj * HALF + 4 * n);
        if (u.pn < 4) {
            const int col0 = 128 * u.pn + wc * 32 + 8 * fq;
#pragma unroll
            for (int ai = 0; ai < 2; ++ai)
#pragma unroll
                for (int m = 0; m < 4; ++m) { bf16* rowp = Z + (size_t)(row0 + ai * HALF + m * 16) * DZ + col0;
                    const f32x4 v0 = (acc[ai][0][m][0] + bv[0][0]) * (acc[ai][1][m][0] + bv[1][0]), v1 = (acc[ai][0][m][1] + bv[0][1]) * (acc[ai][1][m][1] + bv[1][1]);
                    *(u32x4*)rowp = pack8(v0, v1); }
        } else {
            const int col0 = 512 + 256 * (u.pn - 4) + wc * 32 + 8 * fq;
#pragma unroll
            for (int ai = 0; ai < 2; ++ai)
#pragma unroll
                for (int m = 0; m < 4; ++m) { bf16* rowp = Z + (size_t)(row0 + ai * HALF + m * 16) * DZ + col0;
#pragma unroll
                    for (int bj = 0; bj < 2; ++bj) *(u32x4*)(rowp + bj * HALF) = pack8(acc[ai][bj][m][0] + bv[bj][0], acc[ai][bj][m][1] + bv[bj][1]); }
        }
    }
};
__device__ __forceinline__ f32x4 silu_mul(const f32x4 a, const f32x4 b) { f32x4 o;
#pragma unroll
    for (int j = 0; j < 4; ++j) o[j] = a[j] * __builtin_amdgcn_rcpf(1.f + __expf(-a[j])) * b[j];
    return o; }
struct EpiUp {
    static constexpr bool PERM = true, AFTER_DRAIN = false, FP8 = true;
    unsigned char* H;
    __device__ __forceinline__ void operator()(EPI_ARGS) const {
        const int row0 = u.pm * BM + wr * 64 + fr, col0 = 128 * u.pn + wc * 32 + 8 * fq;
#pragma unroll
        for (int ai = 0; ai < 2; ++ai) {
            asm volatile("" ::: "memory");
#pragma unroll
            for (int m = 0; m < 4; ++m) { const f32x4 h0 = silu_mul(acc[ai][0][m][0] * (1.f / W8_SCALE), acc[ai][1][m][0] * (H8_SCALE / W8_SCALE)), h1 = silu_mul(acc[ai][0][m][1] * (1.f / W8_SCALE), acc[ai][1][m][1] * (H8_SCALE / W8_SCALE));
                v2u w; w.x = pk4_fp8(sat8(h0[0]), sat8(h0[1]), sat8(h0[2]), sat8(h0[3])); w.y = pk4_fp8(sat8(h1[0]), sat8(h1[1]), sat8(h1[2]), sat8(h1[3]));
                *(v2u*)(H + (size_t)(row0 + ai * HALF + m * 16) * DEXP + col0) = w; } }
    }
};
struct EpiGate {
    static constexpr bool PERM = true, AFTER_DRAIN = false, FP8 = true;
    bf16* PP; const float* bg;
    __device__ __forceinline__ void operator()(EPI_ARGS) const {
        const int row0 = u.pm * BM + wr * 64 + fr, col0 = u.pn * BM + wc * 32 + 8 * fq;
        f32x4 bv[2][2];
#pragma unroll
        for (int bj = 0; bj < 2; ++bj)
#pragma unroll
            for (int n = 0; n < 2; ++n) bv[bj][n] = *(const f32x4*)(bg + col0 + bj * HALF + 4 * n);
#pragma unroll
        for (int ai = 0; ai < 2; ++ai) {
            v4u pv[4][2];
#pragma unroll
            for (int m = 0; m < 4; ++m)
#pragma unroll
                for (int bj = 0; bj < 2; ++bj) pv[m][bj] = *(const v4u*)(PP + (size_t)(row0 + ai * HALF + m * 16) * D + col0 + bj * HALF);
#pragma unroll
            for (int m = 0; m < 4; ++m)
#pragma unroll
                for (int bj = 0; bj < 2; ++bj) { f32x4 p0, p1; unpack4x2(pv[m][bj], p0, p1); const f32x4 g0 = acc[ai][bj][m][0] * (1.f / W8_SCALE) + bv[bj][0], g1 = acc[ai][bj][m][1] * (1.f / W8_SCALE) + bv[bj][1]; f32x4 o0, o1;
#pragma unroll
                    for (int j = 0; j < 4; ++j) { o0[j] = __builtin_amdgcn_rcpf(1.f + __expf(-g0[j])) * p0[j]; o1[j] = __builtin_amdgcn_rcpf(1.f + __expf(-g1[j])) * p1[j]; }
                    *(u32x4*)(PP + (size_t)(row0 + ai * HALF + m * 16) * D + col0 + bj * HALF) = pack8(o0, o1); }
        }
    }
};
struct EpiDown {
    static constexpr bool PERM = true, AFTER_DRAIN = false, FP8 = true; static constexpr int NSTORE = 16;
    unsigned char* YS;
    __device__ __forceinline__ void operator()(EPI_ARGS) const {
        const int row0 = u.pm * BM + wr * 64 + fr, col0 = u.pn * BM + wc * 32 + 8 * fq; constexpr float sc = Y8_SCALE / (W8_SCALE * H8_SCALE);
#pragma unroll
        for (int ai = 0; ai < 2; ++ai)
#pragma unroll
            for (int m = 0; m < 4; ++m) { unsigned char* rowp = YS + (size_t)(row0 + ai * HALF + m * 16) * D + col0;
#pragma unroll
                for (int bj = 0; bj < 2; ++bj) { const f32x4 a = acc[ai][bj][m][0] * sc, c = acc[ai][bj][m][1] * sc; v2u w; w.x = pk4_fp8(sat8(a[0]), sat8(a[1]), sat8(a[2]), sat8(a[3])); w.y = pk4_fp8(sat8(c[0]), sat8(c[1]), sat8(c[2]), sat8(c[3])); *(v2u*)(rowp + bj * HALF) = w; } }
    }
};

struct EpiRes {
    static constexpr bool PERM = true, AFTER_DRAIN = false, FP8 = false;
    const bf16* xin; bf16* Y;
    __device__ __forceinline__ void operator()(EPI_ARGS) const {
        const int row0 = u.pm * BM + wr * 64 + fr, col0 = u.pn * BM + wc * 32 + 8 * fq;
#pragma unroll
        for (int ai = 0; ai < 2; ++ai) {
            v4u xv[4][2];
#pragma unroll
            for (int m = 0; m < 4; ++m)
#pragma unroll
                for (int bj = 0; bj < 2; ++bj) xv[m][bj] = *(const v4u*)(xin + (size_t)(row0 + ai * HALF + m * 16) * D + col0 + bj * HALF);
#pragma unroll
            for (int m = 0; m < 4; ++m)
#pragma unroll
                for (int bj = 0; bj < 2; ++bj) { f32x4 lo, hi; unpack4x2(xv[m][bj], lo, hi);
                    *(u32x4*)(Y + (size_t)(row0 + ai * HALF + m * 16) * D + col0 + bj * HALF) = pack8(ALPHA * lo + acc[ai][bj][m][0], ALPHA * hi + acc[ai][bj][m][1]); }
        }
    }
};

template <class Epi, class Sched>
__device__ __forceinline__ void gemm_phase(LAS unsigned char* lds, const int K, const Sched& S, const Epi& E) {
    int tid = threadIdx.x; asm volatile("" : "+v"(tid));
    const int wid = __builtin_amdgcn_readfirstlane(tid >> 6), lane = tid & 63, wr = wid >> 2, wc = wid & 3, fr = lane & 15, fq = lane >> 4;
    const int nt = K / BK;
    unsigned voffA[2], voffB[2];
#pragma unroll
    for (int i = 0; i < 2; ++i) { int R, C; stage_rc(tid * 16 + i * 8192, R, C); const int Rb = Epi::PERM ? ((R & ~31) + perm32(R & 31)) : R; voffA[i] = (unsigned)(R * K + C) * 2u; voffB[i] = (unsigned)(Rb * K + C) * 2u; }
    asm volatile("" : "+v"(voffA[0]), "+v"(voffA[1]), "+v"(voffB[0]), "+v"(voffB[1]));
    const size_t kstep = (size_t)(BK * 2);
    const size_t hstep = (size_t)HALF * K * 2;
    const unsigned ldsw = (unsigned)wid * 1024u;
    const int aoff = lds_byte(wr * 64 + fr, fq * 8), boff = lds_byte(wc * 32 + fr, fq * 8);
#define PG8_SA(b, h) (((b) * 2 + (h)) * HTB)
#define PG8_SB(b, h) ((4 + (b) * 2 + (h)) * HTB)
#define PG8_STAGE_B(bufoff, gbase) do { _Pragma("unroll") for (int _i = 0; _i < 2; ++_i) \
        __builtin_amdgcn_global_load_lds((const unsigned*)((const char*)(gbase) + voffB[_i]), (LAS unsigned*)(lds + (bufoff) + ldsw + _i * 8192), 16, 0, 0); } while (0)
#define PG8_STAGE_A(bufoff, gbase, VO, h) do { _Pragma("unroll") for (int _i = 0; _i < 2; ++_i) { \
        if constexpr (Sched::GATHER) __builtin_amdgcn_global_load_lds((const unsigned*)((const char*)(gbase) + (VO)[h][_i]), (LAS unsigned*)(lds + (bufoff) + ldsw + _i * 8192), 16, 0, 0); \
        else __builtin_amdgcn_global_load_lds((const unsigned*)((const char*)(gbase) + (h) * hstep + voffA[_i]), (LAS unsigned*)(lds + (bufoff) + ldsw + _i * 8192), 16, 0, 0); } } while (0)
#define PG8_LDA(dst, b, h) do { _Pragma("unroll") for (int m = 0; m < 4; ++m) { const LAS unsigned char* _p = lds + PG8_SA(b, h) + aoff + m * 2048; \
        dst[m] = __builtin_shufflevector(*(const LAS v4i32*)_p, *(const LAS v4i32*)(_p + 1024), 0, 1, 2, 3, 4, 5, 6, 7); } } while (0)
#define PG8_LDB(dst, b, h) do { _Pragma("unroll") for (int n = 0; n < 2; ++n) { const LAS unsigned char* _p = lds + PG8_SB(b, h) + boff + n * 2048; \
        dst[n] = __builtin_shufflevector(*(const LAS v4i32*)_p, *(const LAS v4i32*)(_p + 1024), 0, 1, 2, 3, 4, 5, 6, 7); } } while (0)
#define PG8_HALF(x, k) __builtin_bit_cast(bf16x8, __builtin_shufflevector((x), (x), 4 * (k), 4 * (k) + 1, 4 * (k) + 2, 4 * (k) + 3))
#define PG8_MMA(ai, bj, At, Bt) do { __builtin_amdgcn_s_setprio(1); _Pragma("unroll") for (int m = 0; m < 4; ++m) _Pragma("unroll") for (int n = 0; n < 2; ++n) { \
        if constexpr (Epi::FP8) asm volatile("v_mfma_f32_16x16x128_f8f6f4 %0, %1, %2, %0" : "+v"(acc[ai][bj][m][n]) : "v"(Bt[n]), "v"(At[m]));   \
        else { acc[ai][bj][m][n] = __builtin_amdgcn_mfma_f32_16x16x32_bf16(PG8_HALF(Bt[n], 0), PG8_HALF(At[m], 0), acc[ai][bj][m][n], 0, 0, 0); \
               acc[ai][bj][m][n] = __builtin_amdgcn_mfma_f32_16x16x32_bf16(PG8_HALF(Bt[n], 1), PG8_HALF(At[m], 1), acc[ai][bj][m][n], 0, 0, 0); } } \
        __builtin_amdgcn_s_setprio(0); } while (0)
#define PG8_WAIT_V(n) asm volatile("s_waitcnt vmcnt(" #n ")" ::: "memory")
#define PG8_WAIT_L(n) asm volatile("s_waitcnt lgkmcnt(" #n ")" ::: "memory")
#define PG8_BAR __builtin_amdgcn_s_barrier()
#define PG8_SCHED __builtin_amdgcn_sched_barrier(0)
    Unit cur, nxt; int ui = 0;
    if (!S.next(0, cur)) return;
    f32x4 acc[2][2][4][2];
#pragma unroll
    for (int a = 0; a < 2; ++a)
#pragma unroll
        for (int b = 0; b < 2; ++b)
#pragma unroll
            for (int m = 0; m < 4; ++m)
#pragma unroll
                for (int n = 0; n < 2; ++n) acc[a][b][m][n] = (f32x4){0.f, 0.f, 0.f, 0.f};
    v8i32 At[4], B0[2], B1[2];
    unsigned vA[2][2], vN[2][2];
    S.a_offs(cur, vA, tid);
    const char* cA = S.a_base(cur); const char* cB = S.b_base(cur);
    PG8_STAGE_B(PG8_SB(0, 0), cB); PG8_STAGE_B(PG8_SB(0, 1), cB + hstep); PG8_STAGE_A(PG8_SA(0, 0), cA, vA, 0); PG8_STAGE_A(PG8_SA(0, 1), cA, vA, 1);
    if (wr == 1) PG8_BAR;
    PG8_WAIT_V(2); PG8_BAR;
    PG8_STAGE_B(PG8_SB(1, 0), cB + kstep); PG8_STAGE_A(PG8_SA(1, 0), cA + kstep, vA, 0); PG8_STAGE_B(PG8_SB(1, 1), cB + hstep + kstep);
    PG8_WAIT_V(6); PG8_BAR;
    for (;;) {
        const bool has_next = S.next(ui + 1, nxt);
        const char* nA = has_next ? S.a_base(nxt) : cA; const char* nB = has_next ? S.b_base(nxt) : cB;
        if constexpr (Sched::GATHER) { if (has_next) S.a_offs(nxt, vN, tid); else {
#pragma unroll
            for (int h = 0; h < 2; ++h)
#pragma unroll
                for (int i = 0; i < 2; ++i) vN[h][i] = vA[h][i]; } }
#pragma nounroll
        for (int t = 0; t < nt; t += 2) {
            const bool last = (t == nt - 2);
            asm volatile("" : "+v"(voffA[0]), "+v"(voffA[1]), "+v"(voffB[0]), "+v"(voffB[1]));
            const char* a1 = cA + (size_t)(t + 1) * kstep;
            const char* a2 = last ? nA : cA + (size_t)(t + 2) * kstep; const char* b2 = last ? nB : cB + (size_t)(t + 2) * kstep;
            const char* a3 = a2 + kstep; const char* b3 = b2 + kstep;
            PG8_LDB(B0, 0, 0); PG8_LDB(B1, 0, 1); PG8_SCHED; PG8_LDA(At, 0, 0); PG8_STAGE_A(PG8_SA(1, 1), a1, vA, 1);
            if constexpr (Sched::GATHER) { if (last) {
#pragma unroll
                for (int h = 0; h < 2; ++h)
#pragma unroll
                    for (int i = 0; i < 2; ++i) vA[h][i] = vN[h][i]; } }
            PG8_WAIT_V(8); PG8_WAIT_L(0); PG8_BAR; PG8_MMA(0, 0, At, B0); PG8_MMA(0, 1, At, B1); PG8_BAR; PG8_SCHED;
            PG8_LDA(At, 0, 1); PG8_STAGE_B(PG8_SB(0, 0), b2); PG8_STAGE_B(PG8_SB(0, 1), b2 + hstep); PG8_STAGE_A(PG8_SA(0, 0), a2, vA, 0);
            PG8_WAIT_V(8); PG8_WAIT_L(0); PG8_BAR; PG8_MMA(1, 0, At, B0); PG8_MMA(1, 1, At, B1); PG8_BAR; PG8_SCHED;
            PG8_LDB(B0, 1, 0); PG8_LDB(B1, 1, 1); PG8_SCHED; PG8_LDA(At, 1, 0); PG8_STAGE_A(PG8_SA(0, 1), a2, vA, 1);
            PG8_WAIT_V(8); PG8_WAIT_L(0); PG8_BAR; PG8_MMA(0, 0, At, B0); PG8_MMA(0, 1, At, B1); PG8_BAR; PG8_SCHED;
            PG8_LDA(At, 1, 1); PG8_STAGE_B(PG8_SB(1, 0), b3); PG8_STAGE_B(PG8_SB(1, 1), b3 + hstep); PG8_STAGE_A(PG8_SA(1, 0), a3, vA, 0);
            PG8_WAIT_V(8); PG8_WAIT_L(0); PG8_BAR; PG8_MMA(1, 0, At, B0); PG8_MMA(1, 1, At, B1); PG8_BAR; PG8_SCHED;
        }
        if constexpr (Epi::FP8) asm volatile("s_nop 15\n\ts_nop 15" ::: "memory");
        if (wr == 0) PG8_BAR;
        if constexpr (!Epi::AFTER_DRAIN) { int t2 = tid; asm volatile("" : "+v"(t2));
            const int w2 = __builtin_amdgcn_readfirstlane(t2 >> 6), l2 = t2 & 63; E(acc, cur, w2 >> 2, w2 & 3, l2 & 15, l2 >> 4); }
        if (!has_next) break;
#pragma unroll
        for (int a = 0; a < 2; ++a)
#pragma unroll
            for (int b = 0; b < 2; ++b)
#pragma unroll
                for (int m = 0; m < 4; ++m)
#pragma unroll
                    for (int n = 0; n < 2; ++n) acc[a][b][m][n] = (f32x4){0.f, 0.f, 0.f, 0.f};
        cur = nxt; cA = nA; cB = nB; ++ui;
        if (wr == 1) PG8_BAR;
    }
    PG8_WAIT_V(0);
    PG8_BAR;
#undef PG8_SA
#undef PG8_SB
#undef PG8_STAGE_A
#undef PG8_STAGE_B
#undef PG8_LDA
#undef PG8_LDB
#undef PG8_MMA
#undef PG8_HALF
#undef PG8_WAIT_V
#undef PG8_WAIT_L
#undef PG8_BAR
#undef PG8_SCHED
}
}
constexpr int NWAVES = 8;
constexpr int RING_BYTES = 131072, EXT_OFF = 139264, LDS_BYTES = 155648;
constexpr int EXT_MISC = 0, EXT_TB = 256, EXT_CT = 512, EXT_T2E = 768, EXT_BIAS = 4096;
constexpr int CW_BAR = 4096;
constexpr int N_PHASES = 17;

#define GAS __attribute__((address_space(1)))
typedef GAS unsigned gu32;
#define RLX_AGENT __ATOMIC_RELAXED, __HIP_MEMORY_SCOPE_AGENT
#define VM_WAIT() asm volatile("s_waitcnt vmcnt(0)" ::: "memory")

#define XB_TMO      128
#define XB_XCNT(j)  (256  + 64 * (j))
#define XB_XSUB(j)  (1280 + 64 * (j))
#define XB_XGEN(j)  (2304 + 64 * (j))
#define XB_TOP      3328
#define XB_TOPGEN   3392
#define XCD_BAR_WORDS 3456
#define XB_SPIN_CAP (1u << 18)
__device__ __forceinline__ unsigned xb_ld(unsigned* p)              { return __hip_atomic_load(p, __ATOMIC_RELAXED, __HIP_MEMORY_SCOPE_AGENT); }
__device__ __forceinline__ unsigned xb_add(unsigned* p, unsigned v) { return __hip_atomic_fetch_add(p, v, __ATOMIC_RELAXED, __HIP_MEMORY_SCOPE_AGENT); }
__device__ __forceinline__ unsigned xb_xcc_id() { return (unsigned)__builtin_amdgcn_s_getreg((3 << 11) | 20) & 0xFu; }
#define XB_SPIN(cond, bar) do { unsigned _sp = 0; while (cond) { __builtin_amdgcn_s_sleep(1); \
    if ((++_sp & 255u) == 0u) { if (xb_ld(&(bar)[XB_TMO])) break; if (_sp > XB_SPIN_CAP) { atomicAdd(&(bar)[XB_TMO], 1u); break; } } } } while (0)
struct XcdBarrier { unsigned* bar; unsigned x; volatile LAS unsigned* st; };
__device__ __forceinline__ XcdBarrier xcd_barrier_post(unsigned* bar, volatile LAS unsigned* st) {
    XcdBarrier b; b.bar = bar; b.x = xb_xcc_id(); b.st = st;
    if (threadIdx.x == 0) (void)xb_add(&bar[XB_XCNT(b.x)], 1u);
    return b;
}
__device__ __forceinline__ void xcd_barrier_complete(unsigned* bar, unsigned x, unsigned& nloc, unsigned& nx) {
    const unsigned G = gridDim.x * gridDim.y * gridDim.z;
    unsigned sum, cnt, mine, sp = 0u;
    for (;;) {
        sum = 0u; cnt = 0u; mine = 0u;
#pragma unroll
        for (unsigned j = 0; j < 16; ++j) { const unsigned c = xb_ld(&bar[XB_XCNT(j)]); sum += c; cnt += (c > 0u) ? 1u : 0u; mine = (j == x) ? c : mine; }
        if (sum == G) break;
        __builtin_amdgcn_s_sleep(1);
        if ((++sp & 255u) == 0u) { if (xb_ld(&bar[XB_TMO])) break; if (sp > XB_SPIN_CAP) { atomicAdd(&bar[XB_TMO], 1u); break; } }
    }
    nloc = mine > 0u ? mine : 1u; nx = cnt > 0u ? cnt : 1u;
}
__device__ __forceinline__ void xcd_barrier(const XcdBarrier& b) {
    asm volatile("s_waitcnt vmcnt(0)" ::: "memory");
    __syncthreads();
    if (threadIdx.x == 0) {
        unsigned* bar = b.bar;
        __builtin_amdgcn_s_waitcnt(0);
        unsigned nloc = b.st[0], nx = b.st[1];
        if (nloc == 0u) { xcd_barrier_complete(bar, b.x, nloc, nx); b.st[0] = nloc; b.st[1] = nx; }
        const unsigned old = xb_add(&bar[XB_XSUB(b.x)], 1u);
        const unsigned gen = old / nloc;
        if (old + 1u == (gen + 1u) * nloc) {
            __builtin_amdgcn_fence(__ATOMIC_RELEASE, "agent");
            asm volatile("s_waitcnt vmcnt(0)" ::: "memory");
            const unsigned og = xb_add(&bar[XB_TOP], 1u);
            const unsigned tg = og / nx;
            if (og + 1u == (tg + 1u) * nx) xb_add(&bar[XB_TOPGEN], 1u);
            else XB_SPIN(xb_ld(&bar[XB_TOPGEN]) == tg, bar);
            __builtin_amdgcn_fence(__ATOMIC_ACQUIRE, "agent");
            xb_add(&bar[XB_XGEN(b.x)], 1u);
            asm volatile("s_waitcnt vmcnt(0)" ::: "memory");
        } else {
            XB_SPIN(xb_ld(&bar[XB_XGEN(b.x)]) == gen, bar);
            __builtin_amdgcn_fence(__ATOMIC_ACQUIRE, "agent");
            asm volatile("s_waitcnt vmcnt(0)" ::: "memory");
        }
    }
    __syncthreads();
}

__device__ __forceinline__ int moe_tables(const unsigned* cnt, LAS unsigned char* ext, int tid) {
    LAS int* tb = (LAS int*)(ext + EXT_TB); LAS int* ct = (LAS int*)(ext + EXT_CT); LAS int* t2e = (LAS int*)(ext + EXT_T2E);
    __syncthreads();
    if (tid < NEXP) ct[tid] = (int)__hip_atomic_load(cnt + tid, RLX_AGENT);
    __syncthreads();
    if (tid == 0) { int t = 0; for (int e = 0; e < NEXP; ++e) { tb[e] = t; t += (ct[e] + 255) >> 8; } tb[NEXP] = t; }
    __syncthreads();
    const int T = tb[NEXP];
    for (int mt = tid; mt < T; mt += NWAVES * 64) { int e = 0; while (e < NEXP - 1 && mt >= tb[e + 1]) ++e; t2e[mt] = e; }
    __syncthreads();
    return 4 * T;
}

__device__ __forceinline__ void unpack8(const v4u x, float (&f)[8]) {
    f[0] = __uint_as_float(x.x << 16); f[1] = __uint_as_float(x.x & 0xffff0000u); f[2] = __uint_as_float(x.y << 16); f[3] = __uint_as_float(x.y & 0xffff0000u);
    f[4] = __uint_as_float(x.z << 16); f[5] = __uint_as_float(x.z & 0xffff0000u); f[6] = __uint_as_float(x.w << 16); f[7] = __uint_as_float(x.w & 0xffff0000u); }
__device__ __forceinline__ void phase_mixer(const Params& p, int l, LAS unsigned char* lds, int vcu, int G, int wave, int lane) {
    constexpr int RU = 64, PITCH = 1040;
    const bf16* Z = (const bf16*)(p.ws + WS_Z); bf16* A2 = (bf16*)(p.ws + WS_A2);
    const float* cw = p.in[I_CONVW] + (size_t)l * 3 * 512; const float* ps = p.in[I_PSCALE] + (size_t)l * 512;
    const bf16* PW = (const bf16*)(p.ws + WS_SMALLW + (size_t)l * SW_LAYER + SW_PW);
    const int c8 = 8 * lane, fr = lane & 15, fq = lane >> 4;
    float w0[8], w1[8], w2[8];
#pragma unroll
    for (int j = 0; j < 8; ++j) { w0[j] = cw[c8 + j]; w1[j] = cw[512 + c8 + j]; w2[j] = cw[1024 + c8 + j]; }
    const int pg = lane >> 4, PWIN = 2 << pg, left = PWIN >> 1, right = PWIN - 1 - left;
    const int g2 = wave >> 1, dh = wave & 1;
    bf16x8 Bf[4][4];
#pragma unroll
    for (int nb = 0; nb < 4; ++nb)
#pragma unroll
        for (int ks = 0; ks < 4; ++ks) { const int d = 64 * dh + 16 * (fr >> 2) + 4 * nb + (fr & 3); Bf[nb][ks] = *(const bf16x8*)(PW + ((size_t)g2 * 128 + d) * 128 + 32 * ks + 8 * fq); }
    float sc[16];
#pragma unroll
    for (int q = 0; q < 16; ++q) sc[q] = ps[128 * g2 + 64 * dh + 16 * fq + q];
    for (int unit = vcu; unit < NTOK / RU; unit += G) {
        const int t0 = unit * RU, tw = t0 + 8 * wave;
        {
            const int tt0 = tw & (SEQ - 1);
            v4u vr[10], gbr[8];
#pragma unroll
            for (int r = 0; r < 10; ++r) { const int tt = tt0 - 1 + r; vr[r] = (v4u){0u, 0u, 0u, 0u}; if (tt >= 0 && tt < SEQ) vr[r] = *(const v4u*)(Z + (size_t)(tw - 1 + r) * DZ + c8); }
#pragma unroll
            for (int r = 0; r < 8; ++r) gbr[r] = *(const v4u*)(Z + (size_t)(tw + r) * DZ + 512 + c8);
#pragma unroll
            for (int r = 0; r < 8; ++r) {
                float a[8], b[8], c[8], g[8], o[8]; unpack8(vr[r], a); unpack8(vr[r + 1], b); unpack8(vr[r + 2], c); unpack8(gbr[r], g);
#pragma unroll
                for (int j = 0; j < 8; ++j) o[j] = g[j] * (w0[j] * a[j] + w1[j] * b[j] + w2[j] * c[j]);
                v4u ov; ov.x = pk2(o[0], o[1]); ov.y = pk2(o[2], o[3]); ov.z = pk2(o[4], o[5]); ov.w = pk2(o[6], o[7]);
                *(v4u*)(A2 + (size_t)(tw + r) * D + c8) = ov; }
        }
        {
            const bf16* U = Z + 1024 + c8; const int tt0 = tw & (SEQ - 1); const size_t seq0 = (size_t)(tw - tt0);
            float S[8];
#pragma unroll
            for (int j = 0; j < 8; ++j) S[j] = 0.f;
            { v4u ld[16];
#pragma unroll
              for (int q = 0; q < 16; ++q) { const int tq = tt0 - left + q, tc = tq < 0 ? 0 : (tq > SEQ - 1 ? SEQ - 1 : tq); ld[q] = *(const v4u*)(U + (seq0 + tc) * DZ); }
#pragma unroll
              for (int q = 0; q < 16; ++q) { const int tq = tt0 - left + q; const float mk = (q < PWIN && tq >= 0 && tq < SEQ) ? 1.f : 0.f; float f[8]; unpack8(ld[q], f);
#pragma unroll
                  for (int j = 0; j < 8; ++j) S[j] += mk * f[j]; } }
            v4u lin[8], lout[8], lself[8];
#pragma unroll
            for (int r = 0; r < 8; ++r) { const int tt = tt0 + r, tin = tt + right, tout = tt - 1 - left;
                lself[r] = *(const v4u*)(U + (seq0 + tt) * DZ);
                lin[r] = *(const v4u*)(U + (seq0 + (tin > SEQ - 1 ? SEQ - 1 : tin)) * DZ); lout[r] = *(const v4u*)(U + (seq0 + (tout < 0 ? 0 : tout)) * DZ); }
#pragma unroll
            for (int r = 0; r < 8; ++r) { const int tt = tt0 + r;
                if (r > 0) { const int tin = tt + right, tout = tt - 1 - left; const float mi = tin < SEQ ? 1.f : 0.f, mo = tout >= 0 ? 1.f : 0.f; float fi[8], fo[8]; unpack8(lin[r], fi); unpack8(lout[r], fo);
#pragma unroll
                    for (int j = 0; j < 8; ++j) S[j] += mi * fi[j] - mo * fo[j]; }
                const int lo = tt - left < 0 ? 0 : tt - left, hi = tt + right > SEQ - 1 ? SEQ - 1 : tt + right; const float inv = 1.f / (float)(hi - lo + 1);
                float f[8], o[8]; unpack8(lself[r], f);
#pragma unroll
                for (int j = 0; j < 8; ++j) o[j] = S[j] * inv - f[j];
                v4u ov; ov.x = pk2(o[0], o[1]); ov.y = pk2(o[2], o[3]); ov.z = pk2(o[4], o[5]); ov.w = pk2(o[6], o[7]);
                *(LAS v4u*)(lds + (8 * wave + r) * PITCH + 16 * lane) = ov; }
        }
        __syncthreads();
#pragma unroll
        for (int mb = 0; mb < 4; ++mb) {
            f32x4 acc[4];
#pragma unroll
            for (int nb = 0; nb < 4; ++nb) acc[nb] = (f32x4){0.f, 0.f, 0.f, 0.f};
#pragma unroll
            for (int ks = 0; ks < 4; ++ks) { const bf16x8 Af = *(const LAS bf16x8*)(lds + (16 * mb + fr) * PITCH + 2 * (128 * g2 + 32 * ks + 8 * fq));
#pragma unroll
                for (int nb = 0; nb < 4; ++nb) acc[nb] = __builtin_amdgcn_mfma_f32_16x16x32_bf16(Bf[nb][ks], Af, acc[nb], 0, 0, 0); }
            bf16* op = A2 + (size_t)(t0 + 16 * mb + fr) * D + 512 + 128 * g2 + 64 * dh + 16 * fq;
            v4u o0, o1;
            o0.x = pk2(acc[0][0] * sc[0], acc[0][1] * sc[1]); o0.y = pk2(acc[0][2] * sc[2], acc[0][3] * sc[3]); o0.z = pk2(acc[1][0] * sc[4], acc[1][1] * sc[5]); o0.w = pk2(acc[1][2] * sc[6], acc[1][3] * sc[7]);
            o1.x = pk2(acc[2][0] * sc[8], acc[2][1] * sc[9]); o1.y = pk2(acc[2][2] * sc[10], acc[2][3] * sc[11]); o1.z = pk2(acc[3][0] * sc[12], acc[3][1] * sc[13]); o1.w = pk2(acc[3][2] * sc[14], acc[3][3] * sc[15]);
            *(v4u*)op = o0; *(v4u*)(op + 8) = o1;
        }
        __syncthreads();
    }
}


constexpr int RT_B = 0, RT_BPITCH = 1040, RT_GB = 99840, RT_LG = 108032, RT_EX = 134656, RT_WT = 135680, RT_LR = 136704, RT_HIST = 137728, RT_CH = 138240, RT_PART = 99840;
static_assert(RT_LG + 8 * 16 * 52 * 4 <= RT_EX && RT_CH + 512 <= 139264, "routing LDS map");
__device__ __forceinline__ void phase_route(const Params& p, int l, LAS unsigned char* lds, int bx, int wave, int lane, int tid, size_t dofs) {
    bf16* X = (bf16*)(p.ws + WS_XH1); unsigned char* XQ = p.ws + WS_XQ;
    const bf16* WR = (const bf16*)(p.ws + WS_SMALLW + (size_t)l * SW_LAYER + SW_WR);
    const int fr = lane & 15, fq = lane >> 4, tok0 = 128 * bx + 16 * wave;
    bf16x8 af[32];
    bf16* xrow = X + (size_t)(tok0 + fr) * D + 8 * fq;
#pragma unroll
    for (int ks = 0; ks < 32; ++ks) af[ks] = *(const bf16x8*)(xrow + 32 * ks);
    { const float* g = p.in[I_LN1G] + (size_t)l * D; const float* b = p.in[I_LN1B] + (size_t)l * D;
      *(LAS f32x4*)(lds + RT_GB + 16 * tid) = tid < 256 ? *(const f32x4*)(g + 4 * tid) : *(const f32x4*)(b + 4 * (tid - 256)); }
#define RT_STAGE_B(half) do { v4u _t[12]; _Pragma("unroll") for (int _i = 0; _i < 12; ++_i) { const int c = tid + 512 * _i, row = c >> 6, cc = c & 63; _t[_i] = *(const v4u*)(WR + (size_t)row * D + 512 * (half) + 8 * cc); } \
        _Pragma("unroll") for (int _i = 0; _i < 12; ++_i) { const int c = tid + 512 * _i, row = c >> 6, cc = c & 63; *(LAS v4u*)(lds + RT_B + row * RT_BPITCH + 16 * cc) = _t[_i]; } } while (0)
    RT_STAGE_B(0);
    float s = 0.f;
#pragma unroll
    for (int ks = 0; ks < 32; ++ks) { f32x4 lo, hi; pg8::unpack4x2(__builtin_bit_cast(v4u, af[ks]), lo, hi); s += ((lo[0] + lo[1]) + (lo[2] + lo[3])) + ((hi[0] + hi[1]) + (hi[2] + hi[3])); }
    s += __shfl_xor(s, 16); s += __shfl_xor(s, 32);
#define RT_PIN() do { _Pragma("unroll") for (int _k = 0; _k < 32; ++_k) asm volatile("" : "+v"(af[_k])); } while (0)
    RT_PIN();
    const float mean = s * (1.f / D); float q = 0.f;
#pragma unroll
    for (int ks = 0; ks < 32; ++ks) { f32x4 lo, hi; pg8::unpack4x2(__builtin_bit_cast(v4u, af[ks]), lo, hi); lo = lo - mean; hi = hi - mean;
        q += ((lo[0] * lo[0] + lo[1] * lo[1]) + (lo[2] * lo[2] + lo[3] * lo[3])) + ((hi[0] * hi[0] + hi[1] * hi[1]) + (hi[2] * hi[2] + hi[3] * hi[3])); }
    q += __shfl_xor(q, 16); q += __shfl_xor(q, 32);
    const float rstd = 1.f / sqrtf(q * (1.f / D) + LN_EPS);
    RT_PIN();
    __syncthreads();
    { const LAS float* GB = (const LAS float*)(lds + RT_GB);
#pragma unroll
      for (int ks = 0; ks < 32; ++ks) { f32x4 lo, hi; pg8::unpack4x2(__builtin_bit_cast(v4u, af[ks]), lo, hi); const int k = 32 * ks + 8 * fq;
          const f32x4 g0 = *(const LAS f32x4*)(GB + k), g1 = *(const LAS f32x4*)(GB + k + 4), b0 = *(const LAS f32x4*)(GB + D + k), b1 = *(const LAS f32x4*)(GB + D + k + 4);
          const f32x4 o0 = (lo - mean) * rstd * g0 + b0, o1 = (hi - mean) * rstd * g1 + b1; const pg8::u32x4 w = pg8::pack8(o0, o1);
          af[ks] = __builtin_bit_cast(bf16x8, w); *(pg8::u32x4*)(xrow + 32 * ks) = w;
          v2u q8; q8.x = pk4_fp8(o0[0], o0[1], o0[2], o0[3]); q8.y = pk4_fp8(o1[0], o1[1], o1[2], o1[3]); *(v2u*)(XQ + (size_t)(tok0 + fr) * D + 32 * ks + 8 * fq) = q8; } }
    f32x4 acc[3];
#pragma unroll
    for (int nb = 0; nb < 3; ++nb) acc[nb] = (f32x4){0.f, 0.f, 0.f, 0.f};
#define RT_MMA(half) do { _Pragma("unroll") for (int k2 = 0; k2 < 16; ++k2) { _Pragma("unroll") for (int nb = 0; nb < 3; ++nb) { \
        const bf16x8 Bh = *(const LAS bf16x8*)(lds + RT_B + (16 * nb + fr) * RT_BPITCH + 2 * (32 * k2 + 8 * fq)), Bl = *(const LAS bf16x8*)(lds + RT_B + (48 + 16 * nb + fr) * RT_BPITCH + 2 * (32 * k2 + 8 * fq)); \
        acc[nb] = __builtin_amdgcn_mfma_f32_16x16x32_bf16(Bh, af[16 * (half) + k2], acc[nb], 0, 0, 0); acc[nb] = __builtin_amdgcn_mfma_f32_16x16x32_bf16(Bl, af[16 * (half) + k2], acc[nb], 0, 0, 0); } } } while (0)
    RT_MMA(0);
    __syncthreads();
    RT_STAGE_B(1);
    __syncthreads();
    RT_MMA(1);
#undef RT_STAGE_B
#undef RT_MMA
    LAS float* Lg = (LAS float*)(lds + RT_LG);
#pragma unroll
    for (int nb = 0; nb < 3; ++nb)
#pragma unroll
        for (int j = 0; j < 4; ++j) Lg[(16 * wave + fr) * 52 + 16 * nb + 4 * fq + j] = acc[nb][j];
    __syncthreads();
    LAS int* EX = (LAS int*)(lds + RT_EX); LAS float* WT = (LAS float*)(lds + RT_WT); LAS int* LR = (LAS int*)(lds + RT_LR); LAS int* HIST = (LAS int*)(lds + RT_HIST); LAS int* CH = (LAS int*)(lds + RT_CH);
    if (tid < 128) {
        const LAS float* r0 = Lg + tid * 52;
        float lg[4];
#pragma unroll
        for (int g = 0; g < 4; ++g) lg[g] = r0[g] + p.in[I_BRG][l * 4 + g];
        int gs = 0; float gm = lg[0];
#pragma unroll
        for (int g = 1; g < 4; ++g) if (lg[g] > gm) { gm = lg[g]; gs = g; }
        float den = 0.f;
#pragma unroll
        for (int g = 0; g < 4; ++g) den += __expf(lg[g] - gm);
        const float g_w = 1.f / den;
        float el[8];
#pragma unroll
        for (int e = 0; e < 8; ++e) el[e] = r0[4 + 8 * gs + e] + p.in[I_BRE][(l * 4 + gs) * 8 + e];
        int i0 = 0; float v0 = el[0];
#pragma unroll
        for (int e = 1; e < 8; ++e) if (el[e] > v0) { v0 = el[e]; i0 = e; }
        int i1 = -1; float v1 = -3.0e38f;
#pragma unroll
        for (int e = 0; e < 8; ++e) if (e != i0 && el[e] > v1) { v1 = el[e]; i1 = e; }
        const float ex = __expf(v1 - v0);
        EX[2 * tid] = gs * 8 + i0; EX[2 * tid + 1] = gs * 8 + i1; WT[2 * tid] = g_w / (1.f + ex); WT[2 * tid + 1] = g_w * ex / (1.f + ex);
    }
    __syncthreads();
    int my_e = 0, my_lr = 0;
    if (wave < 4) {
        my_e = EX[64 * wave + lane]; int my_cnt = 0;
        const unsigned long long below = (1ull << lane) - 1ull;
        for (int x = 0; x < NEXP; ++x) { const unsigned long long mk = __ballot(my_e == x); if (my_e == x) my_lr = __popcll(mk & below); if (lane == x) my_cnt = __popcll(mk); }
        if (lane < NEXP) CH[wave * NEXP + lane] = my_cnt;
    }
    __syncthreads();
    if (wave < 4) { int before = 0; for (int w = 0; w < wave; ++w) before += CH[w * NEXP + my_e]; LR[64 * wave + lane] = my_lr + before; }
    if (tid < NEXP) HIST[tid] = CH[tid] + CH[NEXP + tid] + CH[2 * NEXP + tid] + CH[3 * NEXP + tid];
    __syncthreads();
    if (tid < NEXP) ((int*)(p.ws + WS_HIST + dofs))[bx * NEXP + tid] = HIST[tid];
    if (tid < 128) { const int t = tid, tok = 128 * bx + t;
        int4 rc; rc.x = EX[2 * t]; rc.y = LR[2 * t]; rc.z = EX[2 * t + 1]; rc.w = LR[2 * t + 1]; ((int4*)(p.ws + WS_TOKREC + dofs))[tok] = rc;
        float2 w; w.x = WT[2 * t]; w.y = WT[2 * t + 1]; ((float2*)(p.ws + WS_TOKW + dofs))[tok] = w; }
    __syncthreads();
}
__device__ __forceinline__ void phase_scatter(const Params& p, int l, LAS unsigned char* lds, int bx, int G, int tid, size_t dofs, int cslot) {
    const int* hist = (const int*)(p.ws + WS_HIST + dofs);
    LAS int* PART = (LAS int*)(lds + RT_PART);
    LAS int* BASE = (LAS int*)(lds + RT_HIST); LAS int* TOT = BASE + 32;
    { const int t = tid, e = t & 31, part = t >> 5; int sb = 0, sa = 0;
      int hv[16];
#pragma unroll
      for (int q = 0; q < 16; ++q) { const int w = part * 16 + q; hv[q] = w < G ? hist[w * NEXP + e] : 0; }
#pragma unroll
      for (int q = 0; q < 16; ++q) { sa += hv[q]; if (part * 16 + q < bx) sb += hv[q]; }
      PART[part * 32 + e] = sb; PART[512 + part * 32 + e] = sa; }
    __syncthreads();
    if (tid < NEXP) { int sb = 0, sa = 0; for (int q = 0; q < 16; ++q) { sb += PART[q * 32 + tid]; sa += PART[512 + q * 32 + tid]; } BASE[tid] = sb; TOT[tid] = sa;
        if (bx == 0) ((unsigned*)(p.ws + WS_CTL))[CW_CNT + 64 * cslot + tid] = (unsigned)sa; }
    __syncthreads();
    if (tid < 128) { const int tok = 128 * bx + tid;
        int4 rc = ((const int4*)(p.ws + WS_TOKREC + dofs))[tok];
        rc.y += BASE[rc.x]; rc.w += BASE[rc.z];
        int* list = (int*)(p.ws + WS_LIST + dofs);
        list[(size_t)rc.x * LCAP + rc.y] = 2 * tok;
        list[(size_t)rc.z * LCAP + rc.w] = 2 * tok + 1;
        ((int4*)(p.ws + WS_TOKREC + dofs))[tok] = rc; }
    __syncthreads();
}


__device__ __forceinline__ void phase_ln2(const Params& p, int l, const LAS int* tb, int gw, int NGW, int lane) {
    const bf16* X1 = (const bf16*)(p.ws + WS_XH1); const bf16* PL = (const bf16*)(p.ws + WS_PP); const unsigned char* YS = p.ws + WS_YS; bf16* XO = (bf16*)(p.ws + WS_XH0);
    const int4* REC = (const int4*)(p.ws + WS_TOKREC); const float2* TW = (const float2*)(p.ws + WS_TOKW);
    const float* g = p.in[I_LN2G] + (size_t)l * D; const float* b = p.in[I_LN2B] + (size_t)l * D;
    f32x4 gg[2][2], bb[2][2];
#pragma unroll
    for (int h = 0; h < 2; ++h)
#pragma unroll
        for (int q = 0; q < 2; ++q) { gg[h][q] = *(const f32x4*)(g + 512 * h + 8 * lane + 4 * q); bb[h][q] = *(const f32x4*)(b + 512 * h + 8 * lane + 4 * q); }
    int m = 2 * gw; if (m >= NTOK) return;
    int4 rc[2]; float2 tw[2];
#pragma unroll
    for (int r = 0; r < 2; ++r) { rc[r] = REC[m + r]; tw[r] = TW[m + r]; }
    for (;;) {
        v4u xv[2][2], pv[2][2]; v2u y0[2][2], y1[2][2]; float w0[2], w1[2];
#pragma unroll
        for (int r = 0; r < 2; ++r) { const size_t s0 = (size_t)(256 * tb[rc[r].x] + rc[r].y) * D, s1 = (size_t)(256 * tb[rc[r].z] + rc[r].w) * D; w0[r] = tw[r].x * (1.f / Y8_SCALE); w1[r] = tw[r].y * (1.f / Y8_SCALE);
#pragma unroll
            for (int h = 0; h < 2; ++h) { const size_t o = (size_t)(m + r) * D + 512 * h + 8 * lane;
                xv[r][h] = *(const v4u*)(X1 + o); pv[r][h] = *(const v4u*)(PL + o); y0[r][h] = *(const v2u*)(YS + s0 + 512 * h + 8 * lane); y1[r][h] = *(const v2u*)(YS + s1 + 512 * h + 8 * lane); } }
        const int mn = m + 2 * NGW; const bool more = mn < NTOK;
        if (more) {
#pragma unroll
            for (int r = 0; r < 2; ++r) { rc[r] = REC[mn + r]; tw[r] = TW[mn + r]; } }
#pragma unroll
        for (int r = 0; r < 2; ++r) {
            f32x4 v[2][2]; float s = 0.f;
#pragma unroll
            for (int h = 0; h < 2; ++h) { f32x4 x0, x1, p0, p1, a0, a1, c0, c1; pg8::unpack4x2(xv[r][h], x0, x1); pg8::unpack4x2(pv[r][h], p0, p1); unpack8_fp8(y0[r][h], a0, a1); unpack8_fp8(y1[r][h], c0, c1);
                v[h][0] = ALPHA * x0 + (w0[r] * a0 + w1[r] * c0) + p0; v[h][1] = ALPHA * x1 + (w0[r] * a1 + w1[r] * c1) + p1;
                s += (v[h][0].x + v[h][0].y) + (v[h][0].z + v[h][0].w) + (v[h][1].x + v[h][1].y) + (v[h][1].z + v[h][1].w); }
            const float mean = wave_sum(s) * (1.f / D); float s2 = 0.f;
#pragma unroll
            for (int h = 0; h < 2; ++h)
#pragma unroll
                for (int q = 0; q < 2; ++q) { v[h][q] = v[h][q] - mean; s2 += (v[h][q].x * v[h][q].x + v[h][q].y * v[h][q].y) + (v[h][q].z * v[h][q].z + v[h][q].w * v[h][q].w); }
            const float rstd = 1.f / sqrtf(wave_sum(s2) * (1.f / D) + LN_EPS);
#pragma unroll
            for (int h = 0; h < 2; ++h) { const f32x4 o0 = v[h][0] * rstd * gg[h][0] + bb[h][0], o1 = v[h][1] * rstd * gg[h][1] + bb[h][1]; const size_t o = (size_t)(m + r) * D + 512 * h + 8 * lane;
                if (l == 1) { *(f32x4*)(p.out + o) = o0; *(f32x4*)(p.out + o + 4) = o1; }
                else { v4u w; w.x = pk2(o0.x, o0.y); w.y = pk2(o0.z, o0.w); w.z = pk2(o1.x, o1.y); w.w = pk2(o1.z, o1.w); *(v4u*)(XO + o) = w; } }
        }
        if (!more) break;
        m = mn;
    }
}

__global__ void __launch_bounds__(NWAVES * 64, 2) mk_fwd(Params p) {
    extern __shared__ __attribute__((aligned(16))) unsigned char lds_raw[];
    LAS unsigned char* lds = (LAS unsigned char*)lds_raw;
    LAS unsigned char* ext = lds + EXT_OFF;
    const int tid = threadIdx.x, wave = __builtin_amdgcn_readfirstlane(tid >> 6); int lane = tid & 63;
int ftid = tid;
#define FRESH_LANE() do { asm volatile("" : "+v"(lane)); ftid = tid; asm volatile("" : "+v"(ftid)); } while (0)
    const int G = gridDim.x, bx = blockIdx.x, vcu = (G % 8 == 0) ? (bx % 8) * (G / 8) + bx / 8 : bx;
    const int gw = bx * NWAVES + wave, NGW = G * NWAVES;
    gu32* ctl = (gu32*)(p.ws + WS_CTL);
    for (int u = tid; u < (LDS_BYTES - EXT_OFF) / 4; u += NWAVES * 64) ((LAS unsigned*)ext)[u] = 0u;
    __syncthreads();
    const int lo = p.ph_lo, hi = p.ph_hi;
    XcdBarrier bar; bar.bar = (unsigned*)ctl + CW_BAR; bar.x = 0; bar.st = nullptr;
    if (hi - lo > 1) bar = xcd_barrier_post((unsigned*)ctl + CW_BAR, (volatile LAS unsigned*)(ext + EXT_MISC) + 8);
#ifndef MK_ONLY
#define MK_ONLY -1
#endif
#define PH_ON(j) (MK_ONLY < 0 || MK_ONLY == (j))
#define IN(k) (lo <= (k) && (k) < hi)
#ifndef PROBE_PH
#define PROBE_PH -1
#endif
    unsigned long long pr_acc = 0ull, pr_t0 = 0ull;
#define PR_BEGIN(j) do { if (PROBE_PH == (j)) pr_t0 = __builtin_amdgcn_s_memrealtime(); } while (0)
#define PR_END(j) do { if (PROBE_PH == (j)) pr_acc += __builtin_amdgcn_s_memrealtime() - pr_t0; } while (0)
#define SEAM(k) do { if (IN(k) && IN((k) + 1)) xcd_barrier(bar); } while (0)
    bf16* XH0 = (bf16*)(p.ws + WS_XH0); bf16* XH1 = (bf16*)(p.ws + WS_XH1);

    PR_BEGIN(8);
    if (PH_ON(0) && IN(0)) {
        FRESH_LANE();
        LAS float* scr = (LAS float*)(lds + wave * TSCR_BYTES);
        phase_cvt_small(p, scr, gw, NGW, lane);
        __syncthreads();
        phase_cvt_moe(p, 0, lds, bx, G, ftid);
        phase_ln0_p(p, gw, NGW, lane);
    }
    SEAM(0);
    PR_END(8);
#define MK_LAYER(l) do { \
        const int b = 1 + 8 * l; \
        unsigned char* sw = p.ws + WS_SMALLW + (size_t)l * SW_LAYER; \
        const unsigned* cnt = (const unsigned*)(p.ws + WS_CTL) + CW_CNT + 64 * l; \
        PR_BEGIN(0); \
        if (PH_ON(1) && IN(b)) { \
            FRESH_LANE(); \
            *(LAS f32x4*)(ext + EXT_BIAS + 16 * ftid) = *(const f32x4*)((const float*)(sw + SW_BIN) + 4 * ftid); \
            __syncthreads(); \
            { pg8::DenseOrder S; S.init(XH0, (const bf16*)(sw + SW_WIN), NTOK, DIN, D, G, bx); \
              pg8::EpiPairZ E{(bf16*)(p.ws + WS_Z), (const LAS float*)(ext + EXT_BIAS)}; \
              pg8::gemm_phase(lds, D, S, E); } \
            { pg8::DenseOrder S; S.init((const bf16*)(p.ws + WS_PB) + (size_t)l * NTOK * DPLE, (const bf16*)(sw + SW_WP), NTOK, D, DPLE, G, bx); \
              pg8::EpiPlain E{(bf16*)(p.ws + WS_PP), D}; \
              pg8::gemm_phase(lds, DPLE, S, E); } \
        } \
        SEAM(b); \
        PR_END(0); \
        PR_BEGIN(1); \
        if (PH_ON(2) && IN(b + 1)) { \
            FRESH_LANE(); \
            phase_mixer(p, l, lds, vcu, G, wave, lane); \
            if (l == 1) { phase_cvt_moe(p, 1, lds, bx, G, ftid); } \
        } \
        SEAM(b + 1); \
        PR_END(1); \
        PR_BEGIN(2); \
        if (PH_ON(3) && IN(b + 2)) { \
            pg8::DenseOrder S; S.init((const bf16*)(p.ws + WS_A2), (const bf16*)(sw + SW_WO), NTOK, D, D, G, bx); \
            pg8::EpiRes E{XH0, XH1}; \
            pg8::gemm_phase(lds, D, S, E); \
        } \
        SEAM(b + 2); \
        PR_END(2); \
        const size_t dofs = 0; \
        PR_BEGIN(3); \
        if (PH_ON(4) && IN(b + 3)) { FRESH_LANE(); phase_route(p, l, lds, bx, wave, lane, ftid, dofs); } \
        SEAM(b + 3); \
        PR_END(3); \
        PR_BEGIN(4); \
        if (PH_ON(4) && IN(b + 4)) { FRESH_LANE(); phase_scatter(p, l, lds, bx, G, ftid, dofs, l + 2 * p.pad); } \
        SEAM(b + 4); \
        PR_END(4); \
        PR_BEGIN(5); \
        if (PH_ON(5) && IN(b + 5)) { \
            FRESH_LANE(); \
            const int T4 = moe_tables(cnt, ext, ftid); \
            pg8::MoeOrder<true> S{(const LAS int*)(ext + EXT_TB), (const LAS int*)(ext + EXT_CT), (const LAS int*)(ext + EXT_T2E), T4, G, vcu, D / 2, (const char*)(p.ws + WS_XQ), (const char*)(p.ws + WS_WUP), (size_t)1024 * 1024, (const int*)(p.ws + WS_LIST)}; \
            pg8::EpiUp E{p.ws + WS_H}; \
            pg8::gemm_phase(lds, D / 2, S, E); \
            { const int rem = (T4 & 255), nl = 256 - rem, j = vcu - rem; \
              pg8::ListOrder SG{(j >= 0) ? 1 : 0, j, -1, 512, D / 2, (const char*)(p.ws + WS_XQ), (const char*)(sw + SW_WG)}; \
              pg8::EpiGate EG{(bf16*)(p.ws + WS_PP), p.in[I_BG] + (size_t)l * D}; \
              (void)nl; pg8::gemm_phase(lds, D / 2, SG, EG); } \
        } \
        SEAM(b + 5); \
        PR_END(5); \
        PR_BEGIN(6); \
        if (PH_ON(6) && IN(b + 6)) { \
            FRESH_LANE(); \
            const int T4 = moe_tables(cnt, ext, ftid); \
            pg8::MoeOrder<false> S{(const LAS int*)(ext + EXT_TB), (const LAS int*)(ext + EXT_CT), (const LAS int*)(ext + EXT_T2E), T4, G, vcu, DEXP / 2, (const char*)(p.ws + WS_H), (const char*)(p.ws + WS_WDN), (size_t)1024 * 512, (const int*)(p.ws + WS_LIST)}; \
            pg8::EpiDown E{p.ws + WS_YS}; \
            pg8::gemm_phase(lds, DEXP / 2, S, E); \
            { const int rem = (T4 & 255), nl = 256 - rem, j = vcu - rem; \
              pg8::ListOrder SG{(j >= 0) ? 1 : 0, nl + j, 2 * nl + vcu, 512, D / 2, (const char*)(p.ws + WS_XQ), (const char*)(sw + SW_WG)}; \
              pg8::EpiGate EG{(bf16*)(p.ws + WS_PP), p.in[I_BG] + (size_t)l * D}; \
              pg8::gemm_phase(lds, D / 2, SG, EG); } \
        } \
        SEAM(b + 6); \
        PR_END(6); \
        PR_BEGIN(7); \
        if (PH_ON(7) && IN(b + 7)) { FRESH_LANE(); (void)moe_tables(cnt, ext, ftid); phase_ln2(p, l, (const LAS int*)(ext + EXT_TB), gw, NGW, lane); } \
        SEAM(b + 7); \
        PR_END(7); \
    } while (0)
    MK_LAYER(0);
    MK_LAYER(1);
#undef MK_LAYER
    if (PROBE_PH >= 0 && bx == 0) { const unsigned long long t0 = __builtin_amdgcn_s_memrealtime(); while (__builtin_amdgcn_s_memrealtime() - t0 < 8ull * pr_acc) __builtin_amdgcn_s_sleep(8); }
#undef IN
#undef SEAM
}
#ifndef MK_FUSED
#define MK_FUSED 1
#endif
#ifndef MK_DUP
#define MK_DUP 0x0
#endif
extern "C" void kernel_launch(void* const* d_in, const int* in_sizes, int n_in, void* d_out, int out_size, void* d_ws, size_t ws_size, hipStream_t stream) {
    static int grid = 0;
    if (grid == 0) {
        if (n_in != 24 || in_sizes[0] != NTOK * D || out_size != NTOK * D || ws_size < WS_END) {
            fprintf(stderr, "kernel_launch: unexpected shapes (n_in %d, in0 %d, out %d, ws %zu < %zu); nothing launched\n", n_in, n_in > 0 ? in_sizes[0] : -1, out_size, ws_size, (size_t)WS_END); grid = -1; return; }
        int dev = 0, cus = 0, per_cu = 0;
        if (hipGetDevice(&dev) != hipSuccess || hipDeviceGetAttribute(&cus, hipDeviceAttributeMultiprocessorCount, dev) != hipSuccess) { grid = -1; return; }
        if (hipFuncSetAttribute((const void*)mk_fwd, hipFuncAttributeMaxDynamicSharedMemorySize, LDS_BYTES) != hipSuccess) { fprintf(stderr, "kernel_launch: hipFuncSetAttribute failed\n"); grid = -1; return; }
        if (hipOccupancyMaxActiveBlocksPerMultiprocessor(&per_cu, (const void*)mk_fwd, NWAVES * 64, LDS_BYTES) != hipSuccess || per_cu < 1) { fprintf(stderr, "kernel_launch: occupancy query says %d blocks per CU\n", per_cu); }
        (void)hipGetLastError();
        grid = cus;
        if (grid != 256) { fprintf(stderr, "kernel_launch: built for 256 CUs, device has %d; nothing launched\n", cus); grid = -1; return; }
    }
    if (grid < 0) return;
    (void)hipMemsetAsync((char*)d_ws + WS_CTL, 0, CTL_BYTES, stream);
    Params p{};
    for (int i = 0; i < 24; ++i) p.in[i] = (const float*)d_in[i];
    p.out = (float*)d_out; p.ws = (unsigned char*)d_ws; p.layer = 0; p.ph_lo = 0; p.ph_hi = 0; p.pad = 0;
#if MK_FUSED
    p.ph_lo = 0; p.ph_hi = N_PHASES;
    hipLaunchKernelGGL(mk_fwd, dim3(grid), dim3(NWAVES * 64), LDS_BYTES, stream, p);
#else
    for (int ph = 0; ph < N_PHASES; ++ph) {
        const int k = ph == 0 ? -1 : (ph - 1) % 8;
        p.ph_lo = ph; p.ph_hi = ph + 1; hipLaunchKernelGGL(mk_fwd, dim3(grid), dim3(NWAVES * 64), LDS_BYTES, stream, p);
        if ((MK_DUP >> ph) & 1) { if (k == 2 || k == 3 || k == 4 || k == 7) p.pad = 1; hipLaunchKernelGGL(mk_fwd, dim3(grid), dim3(NWAVES * 64), LDS_BYTES, stream, p); p.pad = 0; }
    }
#endif
}
```

```cpp
#include <hip/hip_runtime.h>
#include <stdio.h>

#define LAS __attribute__((address_space(3)))
typedef unsigned short bf16;
typedef short bf16x8 __attribute__((ext_vector_type(8)));
typedef float f32x4 __attribute__((ext_vector_type(4)));
typedef unsigned v4u __attribute__((ext_vector_type(4)));
typedef unsigned v2u __attribute__((ext_vector_type(2)));

constexpr int NTOK = 32768, SEQ = 8192, D = 1024, DZ = 1536, DIN = 2048, DPLE = 256, DEXP = 512, NEXP = 32, LCAP = 32768;
constexpr int MAXTILES = 288;
constexpr float ALPHA = 1.41421356237309515f;
constexpr float LN_EPS = 1e-5f;
constexpr float W8_SCALE = 32.f, H8_SCALE = 8.f, Y8_SCALE = 8.f;

constexpr size_t MiB = 1u << 20;
constexpr size_t WS_CTL = 0, CTL_BYTES = 1 * MiB;
constexpr size_t WS_SMALLW = 4 * MiB;
constexpr size_t SW_LAYER = 10 * MiB, SW_WIN = 0, SW_WO = 4 * MiB, SW_WG = 6 * MiB, SW_WP = 8 * MiB, SW_PW = 8 * MiB + 512 * 1024, SW_BIN = 8 * MiB + 768 * 1024, SW_WR = 9 * MiB;
constexpr size_t WS_WUP = 24 * MiB, WS_WDN = 88 * MiB;
constexpr size_t WS_XH0 = 120 * MiB, WS_XH1 = 184 * MiB;
constexpr size_t WS_PB = 248 * MiB;
constexpr size_t WS_PP = 280 * MiB;
constexpr size_t WS_LIST = 344 * MiB, WS_LW = 348 * MiB, WS_TOKREC = 352 * MiB;
constexpr size_t WS_TOKW = 352 * MiB + 512 * 1024, WS_HIST = 353 * MiB;
constexpr size_t WS_H = 354 * MiB, WS_YS = 426 * MiB;
constexpr size_t WS_A2 = WS_H, WS_Z = WS_YS;
constexpr size_t WS_XQ = 570 * MiB;
constexpr size_t WS_END = 602 * MiB;
constexpr int CW_CNT = 1024;

__device__ __forceinline__ unsigned f2bf(float f) { unsigned u = __builtin_bit_cast(unsigned, f); return (u + 0x7fffu + ((u >> 16) & 1u)) >> 16; }
__device__ __forceinline__ unsigned pk2(float lo, float hi) { return f2bf(lo) | (f2bf(hi) << 16); }
__device__ __forceinline__ float sat8(float x) { return __builtin_amdgcn_fmed3f(x, -440.f, 440.f); }
__device__ __forceinline__ unsigned pk4_fp8(float a, float b, float c, float d) { int w = 0; w = __builtin_amdgcn_cvt_pk_fp8_f32(a, b, w, false); w = __builtin_amdgcn_cvt_pk_fp8_f32(c, d, w, true); return (unsigned)w; }
typedef float f32x2_t __attribute__((ext_vector_type(2)));
__device__ __forceinline__ void unpack8_fp8(const v2u x, f32x4& lo, f32x4& hi) {
    const f32x2_t a = __builtin_amdgcn_cvt_pk_f32_fp8((int)x.x, false), b = __builtin_amdgcn_cvt_pk_f32_fp8((int)x.x, true), c = __builtin_amdgcn_cvt_pk_f32_fp8((int)x.y, false), d = __builtin_amdgcn_cvt_pk_f32_fp8((int)x.y, true);
    lo[0] = a[0]; lo[1] = a[1]; lo[2] = b[0]; lo[3] = b[1]; hi[0] = c[0]; hi[1] = c[1]; hi[2] = d[0]; hi[3] = d[1]; }
__device__ __forceinline__ float bf2f(bf16 b) { return __builtin_bit_cast(float, ((unsigned)b) << 16); }
__device__ __forceinline__ float wave_sum(float v) {
#pragma unroll
    for (int o = 1; o < 64; o <<= 1) v += __shfl_xor(v, o);
    return v;
}
#define LDS_WAIT() asm volatile("s_waitcnt lgkmcnt(0)" ::: "memory")

struct Params {
    const float* in[24];
    float* out;
    unsigned char* ws;
    int layer, ph_lo, ph_hi, pad;
};
enum { I_X = 0, I_P, I_LN0G, I_LN0B, I_WIN, I_BIN, I_CONVW, I_POOLW, I_PSCALE, I_WO, I_LN1G, I_LN1B, I_WRG, I_BRG, I_WRE, I_BRE, I_W1, I_W3, I_W2, I_WG, I_BG, I_WP, I_LN2G, I_LN2B };

constexpr int TSCR_BYTES = 64 * 65 * 4;
struct TItem { const float* src; bf16* dst; int ldw, ldt, f8; };
__device__ __forceinline__ int pair_row(int c) { return 256 * (c >> 7) + (c & 127); }
__device__ __forceinline__ void titem_load(const TItem& t, f32x4 (&v)[16], int lane) {
    const int lk = lane >> 4, ln = 4 * (lane & 15);
#pragma unroll
    for (int i = 0; i < 16; ++i) v[i] = *(const f32x4*)(t.src + (size_t)(4 * i + lk) * t.ldw + ln);
}
__device__ __forceinline__ void titem_to_lds(const f32x4 (&v)[16], LAS float* scr, int lane) {
    const int lk = lane >> 4, ln = 4 * (lane & 15);
#pragma unroll
    for (int i = 0; i < 16; ++i) { LAS float* d = scr + (4 * i + lk) * 65 + ln; d[0] = v[i].x; d[1] = v[i].y; d[2] = v[i].z; d[3] = v[i].w; }
}
__device__ __forceinline__ unsigned cvt2bf(float lo, float hi) { unsigned r; asm volatile("v_cvt_pk_bf16_f32 %0, %1, %2" : "=v"(r) : "v"(lo), "v"(hi)); return r; }
__device__ __forceinline__ void titem_finish(const TItem& t, const LAS float* scr, int lane) {
    const int c = lane & 7;
#pragma unroll
    for (int j = 0; j < 8; ++j) { const int n = (lane >> 3) + 8 * j; const LAS float* s = scr + (8 * c) * 65 + n;
        v4u o; o.x = cvt2bf(s[0 * 65], s[1 * 65]); o.y = cvt2bf(s[2 * 65], s[3 * 65]); o.z = cvt2bf(s[4 * 65], s[5 * 65]); o.w = cvt2bf(s[6 * 65], s[7 * 65]);
        *(v4u*)(t.dst + (size_t)n * t.ldt + 8 * c) = o; }
}
__device__ __forceinline__ void titem_finish8(const TItem& t, const LAS float* scr, int lane) {
    const int c = lane & 3; unsigned char* d8 = (unsigned char*)t.dst;
#pragma unroll
    for (int j = 0; j < 4; ++j) { const int n = (lane >> 2) + 16 * j; const LAS float* s = scr + (16 * c) * 65 + n; v4u o;
        o.x = pk4_fp8(s[0 * 65] * W8_SCALE, s[1 * 65] * W8_SCALE, s[2 * 65] * W8_SCALE, s[3 * 65] * W8_SCALE); o.y = pk4_fp8(s[4 * 65] * W8_SCALE, s[5 * 65] * W8_SCALE, s[6 * 65] * W8_SCALE, s[7 * 65] * W8_SCALE);
        o.z = pk4_fp8(s[8 * 65] * W8_SCALE, s[9 * 65] * W8_SCALE, s[10 * 65] * W8_SCALE, s[11 * 65] * W8_SCALE); o.w = pk4_fp8(s[12 * 65] * W8_SCALE, s[13 * 65] * W8_SCALE, s[14 * 65] * W8_SCALE, s[15 * 65] * W8_SCALE);
        *(v4u*)(d8 + (size_t)n * t.ldt + 16 * c) = o; }
}
template <class Get> __device__ __forceinline__ void cvt_loop(const Get& get, int nitems, LAS float* scr, int gw, int NGW, int lane) {
    int it = gw; if (it >= nitems) return;
    TItem cur = get(it), nxt = cur; f32x4 v[16];
    titem_load(cur, v, lane);
    for (;;) {
        titem_to_lds(v, scr, lane);
        LDS_WAIT(); asm volatile("" ::: "memory");
        const int nit = it + NGW; const bool more = nit < nitems;
        if (more) { nxt = get(nit); titem_load(nxt, v, lane); }
        if (cur.f8) titem_finish8(cur, scr, lane); else titem_finish(cur, scr, lane);
        LDS_WAIT(); asm volatile("" ::: "memory");
        if (!more) break;
        cur = nxt; it = nit;
    }
}
struct GetSmall { const Params* p;
    __device__ __forceinline__ TItem operator()(int it) const {
        constexpr int I_IN = 16 * 32, I_O = 16 * 16, I_G = 16 * 16, I_PJ = 4 * 16, I_PL = 4 * 4, PER = I_IN + I_O + I_G + I_PJ + I_PL;
        const int l = it / PER; int r = it % PER; unsigned char* sw = p->ws + WS_SMALLW + (size_t)l * SW_LAYER;
        if (r < I_IN) { const int kb = r / 32, nb = r % 32, n0 = 64 * nb; const int reg = n0 >> 9, cc = n0 & 511;
            const int drow = reg == 0 ? pair_row(cc) : reg == 1 ? 1024 + cc : reg == 2 ? pair_row(cc) + 128 : 1536 + cc;
            return TItem{p->in[I_WIN] + (size_t)l * D * DIN + (size_t)(64 * kb) * DIN + n0, (bf16*)(sw + SW_WIN) + (size_t)drow * D + 64 * kb, DIN, D, 0}; }
        r -= I_IN;
        if (r < I_O) { const int kb = r / 16, nb = r % 16; return TItem{p->in[I_WO] + (size_t)l * D * D + (size_t)(64 * kb) * D + 64 * nb, (bf16*)(sw + SW_WO) + (size_t)(64 * nb) * D + 64 * kb, D, D, 0}; }
        r -= I_O;
        if (r < I_G) { const int kb = r / 16, nb = r % 16; return TItem{p->in[I_WG] + (size_t)l * D * D + (size_t)(64 * kb) * D + 64 * nb, (bf16*)(sw + SW_WG + (size_t)(64 * nb) * D + 64 * kb), D, D, 1}; }
        r -= I_G;
        if (r < I_PJ) { const int kb = r / 16, nb = r % 16; return TItem{p->in[I_WP] + (size_t)l * DPLE * D + (size_t)(64 * kb) * D + 64 * nb, (bf16*)(sw + SW_WP) + (size_t)(64 * nb) * DPLE + 64 * kb, D, DPLE, 0}; }
        r -= I_PJ;
        const int g = r / 4, q = r % 4, kb = q / 2, nb = q % 2;
        return TItem{p->in[I_POOLW] + ((size_t)l * 4 + g) * 128 * 128 + (size_t)(64 * kb) * 128 + 64 * nb, (bf16*)(sw + SW_PW) + (size_t)g * 128 * 128 + (size_t)(64 * nb) * 128 + 64 * kb, 128, 128, 0};
    } };
__device__ __forceinline__ void phase_cvt_small(const Params& p, LAS float* scr, int gw, int NGW, int lane) {
    constexpr int PER = 16 * 32 + 16 * 16 + 16 * 16 + 4 * 16 + 4 * 4;
    cvt_loop(GetSmall{&p}, 2 * PER, scr, gw, NGW, lane);
    for (int i = gw * 64 + lane; i < 2 * DIN; i += NGW * 64) {
        const int l = i / DIN, n = i % DIN; int src;
        if (n < 1024) { const int t = n >> 8, h = (n >> 7) & 1, j = n & 127; src = (h ? 1024 : 0) + 128 * t + j; } else if (n < 1536) src = n - 512; else src = n;
        ((float*)(p.ws + WS_SMALLW + (size_t)l * SW_LAYER + SW_BIN))[n] = p.in[I_BIN][(size_t)l * DIN + src];
    }
}
struct WTile { const float* src; unsigned char* dst; int ldw, ldt, kind; };
__device__ __forceinline__ WTile moe_tile(const Params& p, int l, int t, int& n0) {
    unsigned char* WUP = p.ws + WS_WUP; unsigned char* WDN = p.ws + WS_WDN;
    const int e = t / 48; int r = t % 48; const size_t eo = ((size_t)l * NEXP + e);
    if (r < 32) { const int m3 = r >> 4, q = r & 15, kb = q >> 2, nb = q & 3; n0 = 128 * nb;
        return WTile{(m3 ? p.in[I_W3] : p.in[I_W1]) + eo * D * DEXP + (size_t)(256 * kb) * DEXP + 128 * nb, WUP + (size_t)e * 1024 * 1024 + 256 * kb, DEXP, D, m3}; }
    r -= 32; { const int kb = r >> 3, nb = r & 7; n0 = 128 * nb;
        return WTile{p.in[I_W2] + eo * DEXP * D + (size_t)(256 * kb) * D + 128 * nb, WDN + (size_t)e * 1024 * 512 + 256 * kb, D, DEXP, 2}; }
}
__device__ __forceinline__ void wtile_load(const WTile& w, f32x4 (&v)[16], int tid) {
#pragma unroll
    for (int i = 0; i < 16; ++i) { const int idx = tid + 512 * i; v[i] = *(const f32x4*)(w.src + (size_t)(idx >> 5) * w.ldw + 4 * (idx & 31)); }
}
__device__ __forceinline__ void phase_cvt_moe(const Params& p, int l, LAS unsigned char* lds, int bx, int G, int tid) {
    LAS float* scr = (LAS float*)lds;
    int t = bx; if (t >= NEXP * 48) return;
    int n0c = 0, n0n = 0;
    WTile cur = moe_tile(p, l, t, n0c), nxt = cur; f32x4 v[16];
    wtile_load(cur, v, tid);
    const int c_lo = tid & 7, n_lo = (tid >> 3) & 7, wv = tid >> 6;
    for (;;) {
#pragma unroll
        for (int i = 0; i < 16; ++i) { const int idx = tid + 512 * i; LAS float* d = scr + (idx >> 5) * 129 + 4 * (idx & 31); d[0] = v[i].x; d[1] = v[i].y; d[2] = v[i].z; d[3] = v[i].w; }
        __syncthreads();
        const int tn = t + G; const bool more = tn < NEXP * 48;
        if (more) { nxt = moe_tile(p, l, tn, n0n); wtile_load(nxt, v, tid); }
#pragma unroll
        for (int j = 0; j < 4; ++j) { const int n = n_lo + 8 * (wv + 8 * (j & 1)), c = c_lo + 8 * (j >> 1); const LAS float* s = scr + (16 * c) * 129 + n; v4u o;
            o.x = pk4_fp8(s[0 * 129] * W8_SCALE, s[1 * 129] * W8_SCALE, s[2 * 129] * W8_SCALE, s[3 * 129] * W8_SCALE); o.y = pk4_fp8(s[4 * 129] * W8_SCALE, s[5 * 129] * W8_SCALE, s[6 * 129] * W8_SCALE, s[7 * 129] * W8_SCALE);
            o.z = pk4_fp8(s[8 * 129] * W8_SCALE, s[9 * 129] * W8_SCALE, s[10 * 129] * W8_SCALE, s[11 * 129] * W8_SCALE); o.w = pk4_fp8(s[12 * 129] * W8_SCALE, s[13 * 129] * W8_SCALE, s[14 * 129] * W8_SCALE, s[15 * 129] * W8_SCALE);
            const int nn = n0c + n, drow = cur.kind == 2 ? nn : pair_row(nn) + (cur.kind == 1 ? 128 : 0);
            *(v4u*)(cur.dst + (size_t)drow * cur.ldt + 16 * c) = o; }
        __syncthreads();
        if (!more) break;
        cur = nxt; t = tn; n0c = n0n;
    }
}
__device__ __forceinline__ void ln_row2(const float* xrow, const float* g, const float* b, bf16* hrow, int lane) {
    const f32x4* xr = (const f32x4*)xrow + lane;
    f32x4 v[2][4]; float s[2] = {0.f, 0.f};
#pragma unroll
    for (int q = 0; q < 2; ++q)
#pragma unroll
        for (int j = 0; j < 4; ++j) v[q][j] = xr[q * (D / 4) + 64 * j];
#pragma unroll
    for (int q = 0; q < 2; ++q) {
#pragma unroll
        for (int j = 0; j < 4; ++j) s[q] += (v[q][j].x + v[q][j].y) + (v[q][j].z + v[q][j].w);
        const float mean = wave_sum(s[q]) * (1.f / D); float s2 = 0.f;
#pragma unroll
        for (int j = 0; j < 4; ++j) { v[q][j] = v[q][j] - mean; s2 += (v[q][j].x * v[q][j].x + v[q][j].y * v[q][j].y) + (v[q][j].z * v[q][j].z + v[q][j].w * v[q][j].w); }
        const float rstd = 1.f / sqrtf(wave_sum(s2) * (1.f / D) + LN_EPS);
#pragma unroll
        for (int j = 0; j < 4; ++j) { const f32x4 gg = ((const f32x4*)g)[lane + 64 * j], bb = ((const f32x4*)b)[lane + 64 * j];
            const f32x4 o = v[q][j] * rstd * gg + bb;
            v2u w; w.x = pk2(o.x, o.y); w.y = pk2(o.z, o.w); ((v2u*)hrow)[q * (D / 4) + lane + 64 * j] = w; } }
}
__device__ __forceinline__ void phase_ln0_p(const Params& p, int gw, int NGW, int lane) {
    bf16* XH0 = (bf16*)(p.ws + WS_XH0);
    for (int m = 2 * gw; m < NTOK; m += 2 * NGW) ln_row2(p.in[I_X] + (size_t)m * D, p.in[I_LN0G], p.in[I_LN0B], XH0 + (size_t)m * D, lane);
    bf16* PB = (bf16*)(p.ws + WS_PB);
    for (size_t i0 = (size_t)gw * 256; i0 < (size_t)2 * NTOK * DPLE / 8; i0 += (size_t)NGW * 256) {
        f32x4 a[4], b[4];
#pragma unroll
        for (int q = 0; q < 4; ++q) { const size_t i = i0 + 64 * q + lane; a[q] = ((const f32x4*)p.in[I_P])[2 * i]; b[q] = ((const f32x4*)p.in[I_P])[2 * i + 1]; }
#pragma unroll
        for (int q = 0; q < 4; ++q) { const size_t i = i0 + 64 * q + lane; v4u o; o.x = pk2(a[q].x, a[q].y); o.y = pk2(a[q].z, a[q].w); o.z = pk2(b[q].x, b[q].y); o.w = pk2(b[q].z, b[q].w); ((v4u*)PB)[i] = o; } }
    for (int i = gw * 64 + lane; i < 2 * 48 * D; i += NGW * 64) {
        const int l = i / (48 * D), n = (i / D) % 48, k = i % D; float w = 0.f;
        if (n < 4) w = p.in[I_WRG][((size_t)l * D + k) * 4 + n]; else if (n < 36) w = p.in[I_WRE][(((size_t)l * 4 + ((n - 4) >> 3)) * D + k) * 8 + ((n - 4) & 7)];
        const unsigned h = f2bf(w); const float r = w - __builtin_bit_cast(float, h << 16);
        bf16* WR = (bf16*)(p.ws + WS_SMALLW + (size_t)l * SW_LAYER + SW_WR); WR[n * D + k] = (bf16)h; WR[48 * D + n * D + k] = (bf16)f2bf(r); }
}

namespace pg8 {
typedef unsigned u32x4 __attribute__((ext_vector_type(4)));
typedef int v4i32 __attribute__((ext_vector_type(4)));
typedef int v8i32 __attribute__((ext_vector_type(8)));
constexpr int BM = 256, BK = 64, HALF = 128, HTB = HALF * BK * 2, STAGE_BYTES = 8 * HTB, NXCD = 8, WGM = 8;
__device__ __forceinline__ int lds_byte(int r, int c) { const int st = (r >> 4) * 2 + (c >> 5), rr = r & 15, cc = c & 31, ob = rr * 64 + cc * 2; return st * 1024 + (ob ^ (((ob >> 9) & 1) << 5)); }
__device__ __forceinline__ void stage_rc(int b, int& R, int& C) { const int st = b / 1024, sb = b % 1024, swz = sb ^ (((sb >> 9) & 1) << 5); R = (st >> 1) * 16 + swz / 64; C = (st & 1) * 32 + (swz % 64) / 2; }
__device__ __forceinline__ int perm32(int rho) { const int n = rho >> 4, i = rho & 15; return 8 * (i >> 2) + 4 * n + (i & 3); }
__device__ __forceinline__ unsigned cvt_pk_bf16(float lo, float hi) { unsigned r; asm volatile("v_cvt_pk_bf16_f32 %0, %1, %2" : "=v"(r) : "v"(lo), "v"(hi)); return r; }

struct Unit { int pm, pn, e, r0, ce; };

struct DenseOrder {
    static constexpr bool GATHER = false;
    int nM, nN, nwg, G, c, K; const char* A; const char* Bt;
    __device__ __forceinline__ void init(const bf16* A_, const bf16* Bt_, int M, int N, int K_, int G_, int c_) { A = (const char*)A_; Bt = (const char*)Bt_; nM = M / BM; nN = N / BM; nwg = nM * nN; G = G_; c = c_; K = K_; }
    __device__ __forceinline__ bool next(int i, Unit& u) const {
        const long L = (long)i * G + c; if (L >= nwg) return false;
        int wgid = (int)L; { const int q = nwg / NXCD, r = nwg % NXCD, xcd = wgid % NXCD, off = wgid / NXCD; wgid = (xcd < r ? xcd * (q + 1) : r * (q + 1) + (xcd - r) * q) + off; }
        const int nig = WGM * nN, gid = wgid / nig, fm = gid * WGM, gsz = (nM - fm) < WGM ? (nM - fm) : WGM;
        u.pm = fm + ((wgid % nig) % gsz); u.pn = (wgid % nig) / gsz; u.e = 0; u.r0 = 0; u.ce = 0; return true;
    }
    __device__ __forceinline__ const char* a_base(const Unit& u) const { return A + (size_t)u.pm * BM * K * 2; }
    __device__ __forceinline__ const char* b_base(const Unit& u) const { return Bt + (size_t)u.pn * BM * K * 2; }
    __device__ __forceinline__ void a_offs(const Unit&, unsigned (&v)[2][2], int) const {}
};
struct ListOrder {
    static constexpr bool GATHER = false;
    int na, ua, ub0, lim, K; const char* A; const char* Bt;
    __device__ __forceinline__ bool next(int i, Unit& u) const {
        int id; if (i < na) id = ua; else { id = ub0 + 256 * (i - na); if (ub0 < 0 || id >= lim) return false; }
        u.pm = id >> 2; u.pn = id & 3; u.e = 0; u.r0 = 0; u.ce = 0; return true;
    }
    __device__ __forceinline__ const char* a_base(const Unit& u) const { return A + (size_t)u.pm * BM * K * 2; }
    __device__ __forceinline__ const char* b_base(const Unit& u) const { return Bt + (size_t)u.pn * BM * K * 2; }
    __device__ __forceinline__ void a_offs(const Unit&, unsigned (&v)[2][2], int) const {}
};
template <bool GATHER_> struct MoeOrder {
    static constexpr bool GATHER = GATHER_;
    const LAS int* tb; const LAS int* ct; const LAS int* t2e;
    int T4, G, c, K; const char* A; const char* W; size_t wstride; const int* list;
    __device__ __forceinline__ bool next(int i, Unit& u) const {
        const int L = i * G + c; if (L >= T4) return false;
        const int mt = L >> 2, e = t2e[mt];
        u.pm = mt; u.pn = L & 3; u.e = e; u.r0 = 256 * (mt - tb[e]); u.ce = ct[e]; return true;
    }
    __device__ __forceinline__ const char* a_base(const Unit& u) const { return GATHER ? A : A + (size_t)u.pm * BM * K * 2; }
    __device__ __forceinline__ const char* b_base(const Unit& u) const { return W + (size_t)u.e * wstride + (size_t)u.pn * BM * K * 2; }
    __device__ __forceinline__ void a_offs(const Unit& u, unsigned (&v)[2][2], int tid) const {
#pragma unroll
        for (int i = 0; i < 2; ++i) { int R, C; stage_rc(tid * 16 + i * 8192, R, C);
#pragma unroll
            for (int h = 0; h < 2; ++h) { const int rank = u.r0 + HALF * h + R; const int tok = rank < u.ce ? (list[(size_t)u.e * LCAP + rank] >> 1) : 0;
                v[h][i] = (unsigned)(tok * K + C) * 2u; } } }
};

#define EPI_ARGS const f32x4 (&acc)[2][2][4][2], const Unit& u, int wr, int wc, int fr, int fq
__device__ __forceinline__ u32x4 pack8(const f32x4 v0, const f32x4 v1) { u32x4 w; w.x = cvt_pk_bf16(v0[0], v0[1]); w.y = cvt_pk_bf16(v0[2], v0[3]); w.z = cvt_pk_bf16(v1[0], v1[1]); w.w = cvt_pk_bf16(v1[2], v1[3]); return w; }
__device__ __forceinline__ void unpack4x2(const v4u x, f32x4& lo, f32x4& hi) {
    lo[0] = __uint_as_float(x.x << 16); lo[1] = __uint_as_float(x.x & 0xffff0000u); lo[2] = __uint_as_float(x.y << 16); lo[3] = __uint_as_float(x.y & 0xffff0000u);
    hi[0] = __uint_as_float(x.z << 16); hi[1] = __uint_as_float(x.z & 0xffff0000u); hi[2] = __uint_as_float(x.w << 16); hi[3] = __uint_as_float(x.w & 0xffff0000u); }
struct EpiPlain {
    static constexpr bool PERM = true, AFTER_DRAIN = false, FP8 = false;
    bf16* O; int ldc;
    __device__ __forceinline__ void operator()(EPI_ARGS) const {
        const int row0 = u.pm * BM + wr * 64 + fr, col0 = u.pn * BM + wc * 32 + 8 * fq;
#pragma unroll
        for (int ai = 0; ai < 2; ++ai)
#pragma unroll
            for (int m = 0; m < 4; ++m) { bf16* rowp = O + (size_t)(row0 + ai * HALF + m * 16) * ldc + col0;
#pragma unroll
                for (int bj = 0; bj < 2; ++bj) *(u32x4*)(rowp + bj * HALF) = pack8(acc[ai][bj][m][0], acc[ai][bj][m][1]); }
    }
};
struct EpiPairZ {
    static constexpr bool PERM = true, AFTER_DRAIN = false, FP8 = false;
    bf16* Z; const LAS float* bias;
    __device__ __forceinline__ void operator()(EPI_ARGS) const {
        const int row0 = u.pm * BM + wr * 64 + fr, bcol0 = u.pn * BM + wc * 32 + 8 * fq;
        f32x4 bv[2][2];
#pragma unroll
        for (int bj = 0; bj < 2; ++bj)
#pragma unroll
            for (int n = 0; n < 2; ++n) bv[bj][n] = *(const LAS f32x4*)(bias + bcol0 + bj * HALF + 4 * n);
        if (u.pn < 4) {
            const int col0 = 128 * u.pn + wc * 32 + 8 * fq;
#pragma unroll
            for (int ai = 0; ai < 2; ++ai)
#pragma unroll
                for (int m = 0; m < 4; ++m) { bf16* rowp = Z + (size_t)(row0 + ai * HALF + m * 16) * DZ + col0;
                    const f32x4 v0 = (acc[ai][0][m][0] + bv[0][0]) * (acc[ai][1][m][0] + bv[1][0]), v1 = (acc[ai][0][m][1] + bv[0][1]) * (acc[ai][1][m][1] + bv[1][1]);
                    *(u32x4*)rowp = pack8(v0, v1); }
        } else {
            const int col0 = 512 + 256 * (u.pn - 4) + wc * 32 + 8 * fq;
#pragma unroll
            for (int ai = 0; ai < 2; ++ai)
#pragma unroll
                for (int m = 0; m < 4; ++m) { bf16* rowp = Z + (size_t)(row0 + ai * HALF + m * 16) * DZ + col0;
#pragma unroll
                    for (int bj = 0; bj < 2; ++bj) *(u32x4*)(rowp + bj * HALF) = pack8(acc[ai][bj][m][0] + bv[bj][0], acc[ai][bj][m][1] + bv[bj][1]); }
        }
    }
};
__device__ __forceinline__ f32x4 silu_mul(const f32x4 a, const f32x4 b) { f32x4 o;
#pragma unroll
    for (int j = 0; j < 4; ++j) o[j] = a[j] * __builtin_amdgcn_rcpf(1.f + __expf(-a[j])) * b[j];
    return o; }
struct EpiUp {
    static constexpr bool PERM = true, AFTER_DRAIN = false, FP8 = true;
    unsigned char* H;
    __device__ __forceinline__ void operator()(EPI_ARGS) const {
        const int row0 = u.pm * BM + wr * 64 + fr, col0 = 128 * u.pn + wc * 32 + 8 * fq;
#pragma unroll
        for (int ai = 0; ai < 2; ++ai) {
            asm volatile("" ::: "memory");
#pragma unroll
            for (int m = 0; m < 4; ++m) { const f32x4 h0 = silu_mul(acc[ai][0][m][0] * (1.f / W8_SCALE), acc[ai][1][m][0] * (H8_SCALE / W8_SCALE)), h1 = silu_mul(acc[ai][0][m][1] * (1.f / W8_SCALE), acc[ai][1][m][1] * (H8_SCALE / W8_SCALE));
                v2u w; w.x = pk4_fp8(sat8(h0[0]), sat8(h0[1]), sat8(h0[2]), sat8(h0[3])); w.y = pk4_fp8(sat8(h1[0]), sat8(h1[1]), sat8(h1[2]), sat8(h1[3]));
                *(v2u*)(H + (size_t)(row0 + ai * HALF + m * 16) * DEXP + col0) = w; } }
    }
};
struct EpiGate {
    static constexpr bool PERM = true, AFTER_DRAIN = false, FP8 = true;
    bf16* PP; const float* bg;
    __device__ __forceinline__ void operator()(EPI_ARGS) const {
        const int row0 = u.pm * BM + wr * 64 + fr, col0 = u.pn * BM + wc * 32 + 8 * fq;
        f32x4 bv[2][2];
#pragma unroll
        for (int bj = 0; bj < 2; ++bj)
#pragma unroll
            for (int n = 0; n < 2; ++n) bv[bj][n] = *(const f32x4*)(bg + col0 + bj * HALF + 4 * n);
#pragma unroll
        for (int ai = 0; ai < 2; ++ai) {
            v4u pv[4][2];
#pragma unroll
            for (int m = 0; m < 4; ++m)
#pragma unroll
                for (int bj = 0; bj < 2; ++bj) pv[m][bj] = *(const v4u*)(PP + (size_t)(row0 + ai * HALF + m * 16) * D + col0 + bj * HALF);
#pragma unroll
            for (int m = 0; m < 4; ++m)
#pragma unroll
                for (int bj = 0; bj < 2; ++bj) { f32x4 p0, p1; unpack4x2(pv[m][bj], p0, p1); const f32x4 g0 = acc[ai][bj][m][0] * (1.f / W8_SCALE) + bv[bj][0], g1 = acc[ai][bj][m][1] * (1.f / W8_SCALE) + bv[bj][1]; f32x4 o0, o1;
#pragma unroll
                    for (int j = 0; j < 4; ++j) { o0[j] = __builtin_amdgcn_rcpf(1.f + __expf(-g0[j])) * p0[j]; o1[j] = __builtin_amdgcn_rcpf(1.f + __expf(-g1[j])) * p1[j]; }
                    *(u32x4*)(PP + (size_t)(row0 + ai * HALF + m * 16) * D + col0 + bj * HALF) = pack8(o0, o1); }
        }
    }
};
struct EpiDown {
    static constexpr bool PERM = true, AFTER_DRAIN = false, FP8 = true; static constexpr int NSTORE = 16;
    unsigned char* YS;
    __device__ __forceinline__ void operator()(EPI_ARGS) const {
        const int row0 = u.pm * BM + wr * 64 + fr, col0 = u.pn * BM + wc * 32 + 8 * fq; constexpr float sc = Y8_SCALE / (W8_SCALE * H8_SCALE);
#pragma unroll
        for (int ai = 0; ai < 2; ++ai)
#pragma unroll
            for (int m = 0; m < 4; ++m) { unsigned char* rowp = YS + (size_t)(row0 + ai * HALF + m * 16) * D + col0;
#pragma unroll
                for (int bj = 0; bj < 2; ++bj) { const f32x4 a = acc[ai][bj][m][0] * sc, c = acc[ai][bj][m][1] * sc; v2u w; w.x = pk4_fp8(sat8(a[0]), sat8(a[1]), sat8(a[2]), sat8(a[3])); w.y = pk4_fp8(sat8(c[0]), sat8(c[1]), sat8(c[2]), sat8(c[3])); *(v2u*)(rowp + bj * HALF) = w; } }
    }
};

struct EpiRes {
    static constexpr bool PERM = true, AFTER_DRAIN = false, FP8 = false;
    const bf16* xin; bf16* Y;
    __device__ __forceinline__ void operator()(EPI_ARGS) const {
        const int row0 = u.pm * BM + wr * 64 + fr, col0 = u.pn * BM + wc * 32 + 8 * fq;
#pragma unroll
        for (int ai = 0; ai < 2; ++ai) {
            v4u xv[4][2];
#pragma unroll
            for (int m = 0; m < 4; ++m)
#pragma unroll
                for (int bj = 0; bj < 2; ++bj) xv[m][bj] = *(const v4u*)(xin + (size_t)(row0 + ai * HALF + m * 16) * D + col0 + bj * HALF);
#pragma unroll
            for (int m = 0; m < 4; ++m)
#pragma unroll
                for (int bj = 0; bj < 2; ++bj) { f32x4 lo, hi; unpack4x2(xv[m][bj], lo, hi);
                    *(u32x4*)(Y + (size_t)(row0 + ai * HALF + m * 16) * D + col0 + bj * HALF) = pack8(ALPHA * lo + acc[ai][bj][m][0], ALPHA * hi + acc[ai][bj][m][1]); }
        }
    }
};

template <class Epi, class Sched>
__device__ __forceinline__ void gemm_phase(LAS unsigned char* lds, const int K, const Sched& S, const Epi& E) {
    int tid = threadIdx.x; asm volatile("" : "+v"(tid));
    const int wid = __builtin_amdgcn_readfirstlane(tid >> 6), lane = tid & 63, wr = wid >> 2, wc = wid & 3, fr = lane & 15, fq = lane >> 4;
    const int nt = K / BK;
    unsigned voffA[2], voffB[2];
#pragma unroll
    for (int i = 0; i < 2; ++i) { int R, C; stage_rc(tid * 16 + i * 8192, R, C); const int Rb = Epi::PERM ? ((R & ~31) + perm32(R & 31)) : R; voffA[i] = (unsigned)(R * K + C) * 2u; voffB[i] = (unsigned)(Rb * K + C) * 2u; }
    asm volatile("" : "+v"(voffA[0]), "+v"(voffA[1]), "+v"(voffB[0]), "+v"(voffB[1]));
    const size_t kstep = (size_t)(BK * 2);
    const size_t hstep = (size_t)HALF * K * 2;
    const unsigned ldsw = (unsigned)wid * 1024u;
    const int aoff = lds_byte(wr * 64 + fr, fq * 8), boff = lds_byte(wc * 32 + fr, fq * 8);
#define PG8_SA(b, h) (((b) * 2 + (h)) * HTB)
#define PG8_SB(b, h) ((4 + (b) * 2 + (h)) * HTB)
#define PG8_STAGE_B(bufoff, gbase) do { _Pragma("unroll") for (int _i = 0; _i < 2; ++_i) \
        __builtin_amdgcn_global_load_lds((const unsigned*)((const char*)(gbase) + voffB[_i]), (LAS unsigned*)(lds + (bufoff) + ldsw + _i * 8192), 16, 0, 0); } while (0)
#define PG8_STAGE_A(bufoff, gbase, VO, h) do { _Pragma("unroll") for (int _i = 0; _i < 2; ++_i) { \
        if constexpr (Sched::GATHER) __builtin_amdgcn_global_load_lds((const unsigned*)((const char*)(gbase) + (VO)[h][_i]), (LAS unsigned*)(lds + (bufoff) + ldsw + _i * 8192), 16, 0, 0); \
        else __builtin_amdgcn_global_load_lds((const unsigned*)((const char*)(gbase) + (h) * hstep + voffA[_i]), (LAS unsigned*)(lds + (bufoff) + ldsw + _i * 8192), 16, 0, 0); } } while (0)
#define PG8_LDA(dst, b, h) do { _Pragma("unroll") for (int m = 0; m < 4; ++m) { const LAS unsigned char* _p = lds + PG8_SA(b, h) + aoff + m * 2048; \
        dst[m] = __builtin_shufflevector(*(const LAS v4i32*)_p, *(const LAS v4i32*)(_p + 1024), 0, 1, 2, 3, 4, 5, 6, 7); } } while (0)
#define PG8_LDB(dst, b, h) do { _Pragma("unroll") for (int n = 0; n < 2; ++n) { const LAS unsigned char* _p = lds + PG8_SB(b, h) + boff + n * 2048; \
        dst[n] = __builtin_shufflevector(*(const LAS v4i32*)_p, *(const LAS v4i32*)(_p + 1024), 0, 1, 2, 3, 4, 5, 6, 7); } } while (0)
#define PG8_HALF(x, k) __builtin_bit_cast(bf16x8, __builtin_shufflevector((x), (x), 4 * (k), 4 * (k) + 1, 4 * (k) + 2, 4 * (k) + 3))
#define PG8_MMA(ai, bj, At, Bt) do { __builtin_amdgcn_s_setprio(1); _Pragma("unroll") for (int m = 0; m < 4; ++m) _Pragma("unroll") for (int n = 0; n < 2; ++n) { \
        if constexpr (Epi::FP8) asm volatile("v_mfma_f32_16x16x128_f8f6f4 %0, %1, %2, %0" : "+v"(acc[ai][bj][m][n]) : "v"(Bt[n]), "v"(At[m]));   \
        else { acc[ai][bj][m][n] = __builtin_amdgcn_mfma_f32_16x16x32_bf16(PG8_HALF(Bt[n], 0), PG8_HALF(At[m], 0), acc[ai][bj][m][n], 0, 0, 0); \
               acc[ai][bj][m][n] = __builtin_amdgcn_mfma_f32_16x16x32_bf16(PG8_HALF(Bt[n], 1), PG8_HALF(At[m], 1), acc[ai][bj][m][n], 0, 0, 0); } } \
        __builtin_amdgcn_s_setprio(0); } while (0)
#define PG8_WAIT_V(n) asm volatile("s_waitcnt vmcnt(" #n ")" ::: "memory")
#define PG8_WAIT_L(n) asm volatile("s_waitcnt lgkmcnt(" #n ")" ::: "memory")
#define PG8_BAR __builtin_amdgcn_s_barrier()
#define PG8_SCHED __builtin_amdgcn_sched_barrier(0)
    Unit cur, nxt; int ui = 0;
    if (!S.next(0, cur)) return;
    f32x4 acc[2][2][4][2];
#pragma unroll
    for (int a = 0; a < 2; ++a)
#pragma unroll
        for (int b = 0; b < 2; ++b)
#pragma unroll
            for (int m = 0; m < 4; ++m)
#pragma unroll
                for (int n = 0; n < 2; ++n) acc[a][b][m][n] = (f32x4){0.f, 0.f, 0.f, 0.f};
    v8i32 At[4], B0[2], B1[2];
    unsigned vA[2][2], vN[2][2];
    S.a_offs(cur, vA, tid);
    const char* cA = S.a_base(cur); const char* cB = S.b_base(cur);
    PG8_STAGE_B(PG8_SB(0, 0), cB); PG8_STAGE_B(PG8_SB(0, 1), cB + hstep); PG8_STAGE_A(PG8_SA(0, 0), cA, vA, 0); PG8_STAGE_A(PG8_SA(0, 1), cA, vA, 1);
    if (wr == 1) PG8_BAR;
    PG8_WAIT_V(2); PG8_BAR;
    PG8_STAGE_B(PG8_SB(1, 0), cB + kstep); PG8_STAGE_A(PG8_SA(1, 0), cA + kstep, vA, 0); PG8_STAGE_B(PG8_SB(1, 1), cB + hstep + kstep);
    PG8_WAIT_V(6); PG8_BAR;
    for (;;) {
        const bool has_next = S.next(ui + 1, nxt);
        const char* nA = has_next ? S.a_base(nxt) : cA; const char* nB = has_next ? S.b_base(nxt) : cB;
        if constexpr (Sched::GATHER) { if (has_next) S.a_offs(nxt, vN, tid); else {
#pragma unroll
            for (int h = 0; h < 2; ++h)
#pragma unroll
                for (int i = 0; i < 2; ++i) vN[h][i] = vA[h][i]; } }
#pragma nounroll
        for (int t = 0; t < nt; t += 2) {
            const bool last = (t == nt - 2);
            asm volatile("" : "+v"(voffA[0]), "+v"(voffA[1]), "+v"(voffB[0]), "+v"(voffB[1]));
            const char* a1 = cA + (size_t)(t + 1) * kstep;
            const char* a2 = last ? nA : cA + (size_t)(t + 2) * kstep; const char* b2 = last ? nB : cB + (size_t)(t + 2) * kstep;
            const char* a3 = a2 + kstep; const char* b3 = b2 + kstep;
            PG8_LDB(B0, 0, 0); PG8_LDB(B1, 0, 1); PG8_SCHED; PG8_LDA(At, 0, 0); PG8_STAGE_A(PG8_SA(1, 1), a1, vA, 1);
            if constexpr (Sched::GATHER) { if (last) {
#pragma unroll
                for (int h = 0; h < 2; ++h)
#pragma unroll
                    for (int i = 0; i < 2; ++i) vA[h][i] = vN[h][i]; } }
            PG8_WAIT_V(8); PG8_WAIT_L(0); PG8_BAR; PG8_MMA(0, 0, At, B0); PG8_MMA(0, 1, At, B1); PG8_BAR; PG8_SCHED;
            PG8_LDA(At, 0, 1); PG8_STAGE_B(PG8_SB(0, 0), b2); PG8_STAGE_B(PG8_SB(0, 1), b2 + hstep); PG8_STAGE_A(PG8_SA(0, 0), a2, vA, 0);
            PG8_WAIT_V(8); PG8_WAIT_L(0); PG8_BAR; PG8_MMA(1, 0, At, B0); PG8_MMA(1, 1, At, B1); PG8_BAR; PG8_SCHED;
            PG8_LDB(B0, 1, 0); PG8_LDB(B1, 1, 1); PG8_SCHED; PG8_LDA(At, 1, 0); PG8_STAGE_A(PG8_SA(0, 1), a2, vA, 1);
            PG8_WAIT_V(8); PG8_WAIT_L(0); PG8_BAR; PG8_MMA(0, 0, At, B0); PG8_MMA(0, 1, At, B1); PG8_BAR; PG8_SCHED;
            PG8_LDA(At, 1, 1); PG8_STAGE_B(PG8_SB(1, 0), b3); PG8_STAGE_B(PG8_SB(1, 1), b3 + hstep); PG8_STAGE_A(PG8_SA(1, 0), a3, vA, 0);
            PG8_WAIT_V(8); PG8_WAIT_L(0); PG8_BAR; PG8_MMA(1, 0, At, B0); PG8_MMA(1, 1, At, B1); PG8_BAR; PG8_SCHED;
        }
        if constexpr (Epi::FP8) asm volatile("s_nop 15\n\ts_nop 15" ::: "memory");
        if (wr == 0) PG8_BAR;
        if constexpr (!Epi::AFTER_DRAIN) { int t2 = tid; asm volatile("" : "+v"(t2));
            const int w2 = __builtin_amdgcn_readfirstlane(t2 >> 6), l2 = t2 & 63; E(acc, cur, w2 >> 2, w2 & 3, l2 & 15, l2 >> 4); }
        if (!has_next) break;
#pragma unroll
        for (int a = 0; a < 2; ++a)
#pragma unroll
            for (int b = 0; b < 2; ++b)
#pragma unroll
                for (int m = 0; m < 4; ++m)
#pragma unroll
                    for (int n = 0; n < 2; ++n) acc[a][b][m][n] = (f32x4){0.f, 0.f, 0.f, 0.f};
        cur = nxt; cA = nA; cB = nB; ++ui;
        if (wr == 1) PG8_BAR;
    }
    PG8_WAIT_V(0);
    PG8_BAR;
#undef PG8_SA
#undef PG8_SB
#undef PG8_STAGE_A
#undef PG8_STAGE_B
#undef PG8_LDA
#undef PG8_LDB
#undef PG8_MMA
#undef PG8_HALF
#undef PG8_WAIT_V
#undef PG8_WAIT_L
#undef PG8_BAR
#undef PG8_SCHED
}
}
constexpr int NWAVES = 8;
constexpr int RING_BYTES = 131072, EXT_OFF = 139264, LDS_BYTES = 155648;
constexpr int EXT_MISC = 0, EXT_TB = 256, EXT_CT = 512, EXT_T2E = 768, EXT_BIAS = 4096;
constexpr int CW_BAR = 4096;
constexpr int N_PHASES = 17;

#define GAS __attribute__((address_space(1)))
typedef GAS unsigned gu32;
#define RLX_AGENT __ATOMIC_RELAXED, __HIP_MEMORY_SCOPE_AGENT
#define VM_WAIT() asm volatile("s_waitcnt vmcnt(0)" ::: "memory")

#define XB_TMO      128
#define XB_XCNT(j)  (256  + 64 * (j))
#define XB_XSUB(j)  (1280 + 64 * (j))
#define XB_XGEN(j)  (2304 + 64 * (j))
#define XB_TOP      3328
#define XB_TOPGEN   3392
#define XCD_BAR_WORDS 3456
#define XB_SPIN_CAP (1u << 18)
__device__ __forceinline__ unsigned xb_ld(unsigned* p)              { return __hip_atomic_load(p, __ATOMIC_RELAXED, __HIP_MEMORY_SCOPE_AGENT); }
__device__ __forceinline__ unsigned xb_add(unsigned* p, unsigned v) { return __hip_atomic_fetch_add(p, v, __ATOMIC_RELAXED, __HIP_MEMORY_SCOPE_AGENT); }
__device__ __forceinline__ unsigned xb_xcc_id() { return (unsigned)__builtin_amdgcn_s_getreg((3 << 11) | 20) & 0xFu; }
#define XB_SPIN(cond, bar) do { unsigned _sp = 0; while (cond) { __builtin_amdgcn_s_sleep(1); \
    if ((++_sp & 255u) == 0u) { if (xb_ld(&(bar)[XB_TMO])) break; if (_sp > XB_SPIN_CAP) { atomicAdd(&(bar)[XB_TMO], 1u); break; } } } } while (0)
struct XcdBarrier { unsigned* bar; unsigned x; volatile LAS unsigned* st; };
__device__ __forceinline__ XcdBarrier xcd_barrier_post(unsigned* bar, volatile LAS unsigned* st) {
    XcdBarrier b; b.bar = bar; b.x = xb_xcc_id(); b.st = st;
    if (threadIdx.x == 0) (void)xb_add(&bar[XB_XCNT(b.x)], 1u);
    return b;
}
__device__ __forceinline__ void xcd_barrier_complete(unsigned* bar, unsigned x, unsigned& nloc, unsigned& nx) {
    const unsigned G = gridDim.x * gridDim.y * gridDim.z;
    unsigned sum, cnt, mine, sp = 0u;
    for (;;) {
        sum = 0u; cnt = 0u; mine = 0u;
#pragma unroll
        for (unsigned j = 0; j < 16; ++j) { const unsigned c = xb_ld(&bar[XB_XCNT(j)]); sum += c; cnt += (c > 0u) ? 1u : 0u; mine = (j == x) ? c : mine; }
        if (sum == G) break;
        __builtin_amdgcn_s_sleep(1);
        if ((++sp & 255u) == 0u) { if (xb_ld(&bar[XB_TMO])) break; if (sp > XB_SPIN_CAP) { atomicAdd(&bar[XB_TMO], 1u); break; } }
    }
    nloc = mine > 0u ? mine : 1u; nx = cnt > 0u ? cnt : 1u;
}
__device__ __forceinline__ void xcd_barrier(const XcdBarrier& b) {
    asm volatile("s_waitcnt vmcnt(0)" ::: "memory");
    __syncthreads();
    if (threadIdx.x == 0) {
        unsigned* bar = b.bar;
        __builtin_amdgcn_s_waitcnt(0);
        unsigned nloc = b.st[0], nx = b.st[1];
        if (nloc == 0u) { xcd_barrier_complete(bar, b.x, nloc, nx); b.st[0] = nloc; b.st[1] = nx; }
        const unsigned old = xb_add(&bar[XB_XSUB(b.x)], 1u);
        const unsigned gen = old / nloc;
        if (old + 1u == (gen + 1u) * nloc) {
            __builtin_amdgcn_fence(__ATOMIC_RELEASE, "agent");
            asm volatile("s_waitcnt vmcnt(0)" ::: "memory");
            const unsigned og = xb_add(&bar[XB_TOP], 1u);
            const unsigned tg = og / nx;
            if (og + 1u == (tg + 1u) * nx) xb_add(&bar[XB_TOPGEN], 1u);
            else XB_SPIN(xb_ld(&bar[XB_TOPGEN]) == tg, bar);
            __builtin_amdgcn_fence(__ATOMIC_ACQUIRE, "agent");
            xb_add(&bar[XB_XGEN(b.x)], 1u);
            asm volatile("s_waitcnt vmcnt(0)" ::: "memory");
        } else {
            XB_SPIN(xb_ld(&bar[XB_XGEN(b.x)]) == gen, bar);
            __builtin_amdgcn_fence(__ATOMIC_ACQUIRE, "agent");
            asm volatile("s_waitcnt vmcnt(0)" ::: "memory");
        }
    }
    __syncthreads();
}

constexpr int CW_TBL = 8192, TBL_WORDS = 65 + 288;
__device__ __forceinline__ int moe_tables(const unsigned* tbl, LAS unsigned char* ext, int tid) {
    LAS int* tb = (LAS int*)(ext + EXT_TB); LAS int* ct = (LAS int*)(ext + EXT_CT); LAS int* t2e = (LAS int*)(ext + EXT_T2E);
    __syncthreads();
    if (tid < TBL_WORDS) { const int v = (int)tbl[tid]; if (tid < 33) tb[tid] = v; else if (tid < 65) ct[tid - 33] = v; else t2e[tid - 65] = v; }
    __syncthreads();
    return 4 * tb[NEXP];
}

__device__ __forceinline__ void unpack8(const v4u x, float (&f)[8]) {
    f[0] = __uint_as_float(x.x << 16); f[1] = __uint_as_float(x.x & 0xffff0000u); f[2] = __uint_as_float(x.y << 16); f[3] = __uint_as_float(x.y & 0xffff0000u);
    f[4] = __uint_as_float(x.z << 16); f[5] = __uint_as_float(x.z & 0xffff0000u); f[6] = __uint_as_float(x.w << 16); f[7] = __uint_as_float(x.w & 0xffff0000u); }
__device__ __forceinline__ void phase_mixer(const Params& p, int l, LAS unsigned char* lds, int vcu, int G, int wave, int lane) {
    constexpr int RU = 64, PITCH = 1040;
    const bf16* Z = (const bf16*)(p.ws + WS_Z); bf16* A2 = (bf16*)(p.ws + WS_A2);
    const float* cw = p.in[I_CONVW] + (size_t)l * 3 * 512; const float* ps = p.in[I_PSCALE] + (size_t)l * 512;
    const bf16* PW = (const bf16*)(p.ws + WS_SMALLW + (size_t)l * SW_LAYER + SW_PW);
    const int c8 = 8 * lane, fr = lane & 15, fq = lane >> 4;
    float w0[8], w1[8], w2[8];
#pragma unroll
    for (int j = 0; j < 8; ++j) { w0[j] = cw[c8 + j]; w1[j] = cw[512 + c8 + j]; w2[j] = cw[1024 + c8 + j]; }
    const int pg = lane >> 4, PWIN = 2 << pg, left = PWIN >> 1, right = PWIN - 1 - left;
    const int g2 = wave >> 1, dh = wave & 1;
    bf16x8 Bf[4][4];
#pragma unroll
    for (int nb = 0; nb < 4; ++nb)
#pragma unroll
        for (int ks = 0; ks < 4; ++ks) { const int d = 64 * dh + 16 * (fr >> 2) + 4 * nb + (fr & 3); Bf[nb][ks] = *(const bf16x8*)(PW + ((size_t)g2 * 128 + d) * 128 + 32 * ks + 8 * fq); }
    float sc[16];
#pragma unroll
    for (int q = 0; q < 16; ++q) sc[q] = ps[128 * g2 + 64 * dh + 16 * fq + q];
    for (int unit = vcu; unit < NTOK / RU; unit += G) {
        const int t0 = unit * RU, tw = t0 + 8 * wave;
        {
            const int tt0 = tw & (SEQ - 1);
            v4u vr[10], gbr[8];
#pragma unroll
            for (int r = 0; r < 10; ++r) { const int tt = tt0 - 1 + r; vr[r] = (v4u){0u, 0u, 0u, 0u}; if (tt >= 0 && tt < SEQ) vr[r] = *(const v4u*)(Z + (size_t)(tw - 1 + r) * DZ + c8); }
#pragma unroll
            for (int r = 0; r < 8; ++r) gbr[r] = *(const v4u*)(Z + (size_t)(tw + r) * DZ + 512 + c8);
#pragma unroll
            for (int r = 0; r < 8; ++r) {
                float a[8], b[8], c[8], g[8], o[8]; unpack8(vr[r], a); unpack8(vr[r + 1], b); unpack8(vr[r + 2], c); unpack8(gbr[r], g);
#pragma unroll
                for (int j = 0; j < 8; ++j) o[j] = g[j] * (w0[j] * a[j] + w1[j] * b[j] + w2[j] * c[j]);
                v4u ov; ov.x = pk2(o[0], o[1]); ov.y = pk2(o[2], o[3]); ov.z = pk2(o[4], o[5]); ov.w = pk2(o[6], o[7]);
                *(v4u*)(A2 + (size_t)(tw + r) * D + c8) = ov; }
        }
        {
            const bf16* U = Z + 1024 + c8; const int tt0 = tw & (SEQ - 1); const size_t seq0 = (size_t)(tw - tt0);
            float S[8];
#pragma unroll
            for (int j = 0; j < 8; ++j) S[j] = 0.f;
            { v4u ld[16];
#pragma unroll
              for (int q = 0; q < 16; ++q) { const int tq = tt0 - left + q, tc = tq < 0 ? 0 : (tq > SEQ - 1 ? SEQ - 1 : tq); ld[q] = *(const v4u*)(U + (seq0 + tc) * DZ); }
#pragma unroll
              for (int q = 0; q < 16; ++q) { const int tq = tt0 - left + q; const float mk = (q < PWIN && tq >= 0 && tq < SEQ) ? 1.f : 0.f; float f[8]; unpack8(ld[q], f);
#pragma unroll
                  for (int j = 0; j < 8; ++j) S[j] += mk * f[j]; } }
            v4u lin[8], lout[8], lself[8];
#pragma unroll
            for (int r = 0; r < 8; ++r) { const int tt = tt0 + r, tin = tt + right, tout = tt - 1 - left;
                lself[r] = *(const v4u*)(U + (seq0 + tt) * DZ);
                lin[r] = *(const v4u*)(U + (seq0 + (tin > SEQ - 1 ? SEQ - 1 : tin)) * DZ); lout[r] = *(const v4u*)(U + (seq0 + (tout < 0 ? 0 : tout)) * DZ); }
#pragma unroll
            for (int r = 0; r < 8; ++r) { const int tt = tt0 + r;
                if (r > 0) { const int tin = tt + right, tout = tt - 1 - left; const float mi = tin < SEQ ? 1.f : 0.f, mo = tout >= 0 ? 1.f : 0.f; float fi[8], fo[8]; unpack8(lin[r], fi); unpack8(lout[r], fo);
#pragma unroll
                    for (int j = 0; j < 8; ++j) S[j] += mi * fi[j] - mo * fo[j]; }
                const int lo = tt - left < 0 ? 0 : tt - left, hi = tt + right > SEQ - 1 ? SEQ - 1 : tt + right; const float inv = 1.f / (float)(hi - lo + 1);
                float f[8], o[8]; unpack8(lself[r], f);
#pragma unroll
                for (int j = 0; j < 8; ++j) o[j] = S[j] * inv - f[j];
                v4u ov; ov.x = pk2(o[0], o[1]); ov.y = pk2(o[2], o[3]); ov.z = pk2(o[4], o[5]); ov.w = pk2(o[6], o[7]);
                *(LAS v4u*)(lds + (8 * wave + r) * PITCH + 16 * lane) = ov; }
        }
        __syncthreads();
#pragma unroll
        for (int mb = 0; mb < 4; ++mb) {
            f32x4 acc[4];
#pragma unroll
            for (int nb = 0; nb < 4; ++nb) acc[nb] = (f32x4){0.f, 0.f, 0.f, 0.f};
#pragma unroll
            for (int ks = 0; ks < 4; ++ks) { const bf16x8 Af = *(const LAS bf16x8*)(lds + (16 * mb + fr) * PITCH + 2 * (128 * g2 + 32 * ks + 8 * fq));
#pragma unroll
                for (int nb = 0; nb < 4; ++nb) acc[nb] = __builtin_amdgcn_mfma_f32_16x16x32_bf16(Bf[nb][ks], Af, acc[nb], 0, 0, 0); }
            bf16* op = A2 + (size_t)(t0 + 16 * mb + fr) * D + 512 + 128 * g2 + 64 * dh + 16 * fq;
            v4u o0, o1;
            o0.x = pk2(acc[0][0] * sc[0], acc[0][1] * sc[1]); o0.y = pk2(acc[0][2] * sc[2], acc[0][3] * sc[3]); o0.z = pk2(acc[1][0] * sc[4], acc[1][1] * sc[5]); o0.w = pk2(acc[1][2] * sc[6], acc[1][3] * sc[7]);
            o1.x = pk2(acc[2][0] * sc[8], acc[2][1] * sc[9]); o1.y = pk2(acc[2][2] * sc[10], acc[2][3] * sc[11]); o1.z = pk2(acc[3][0] * sc[12], acc[3][1] * sc[13]); o1.w = pk2(acc[3][2] * sc[14], acc[3][3] * sc[15]);
            *(v4u*)op = o0; *(v4u*)(op + 8) = o1;
        }
        __syncthreads();
    }
}


constexpr int RT_B = 0, RT_BPITCH = 1040, RT_GB = 99840, RT_LG = 108032, RT_EX = 134656, RT_WT = 135680, RT_LR = 136704, RT_HIST = 137728, RT_CH = 138240, RT_PART = 99840;
static_assert(RT_LG + 8 * 16 * 52 * 4 <= RT_EX && RT_CH + 512 <= 139264, "routing LDS map");
__device__ __forceinline__ void phase_route(const Params& p, int l, LAS unsigned char* lds, int bx, int wave, int lane, int tid, size_t dofs) {
    bf16* X = (bf16*)(p.ws + WS_XH1); unsigned char* XQ = p.ws + WS_XQ;
    const bf16* WR = (const bf16*)(p.ws + WS_SMALLW + (size_t)l * SW_LAYER + SW_WR);
    const int fr = lane & 15, fq = lane >> 4, tok0 = 128 * bx + 16 * wave;
    bf16x8 af[32];
    bf16* xrow = X + (size_t)(tok0 + fr) * D + 8 * fq;
#pragma unroll
    for (int ks = 0; ks < 32; ++ks) af[ks] = *(const bf16x8*)(xrow + 32 * ks);
    { const float* g = p.in[I_LN1G] + (size_t)l * D; const float* b = p.in[I_LN1B] + (size_t)l * D;
      *(LAS f32x4*)(lds + RT_GB + 16 * tid) = tid < 256 ? *(const f32x4*)(g + 4 * tid) : *(const f32x4*)(b + 4 * (tid - 256)); }
#define RT_STAGE_B(half) do { v4u _t[12]; _Pragma("unroll") for (int _i = 0; _i < 12; ++_i) { const int c = tid + 512 * _i, row = c >> 6, cc = c & 63; _t[_i] = *(const v4u*)(WR + (size_t)row * D + 512 * (half) + 8 * cc); } \
        _Pragma("unroll") for (int _i = 0; _i < 12; ++_i) { const int c = tid + 512 * _i, row = c >> 6, cc = c & 63; *(LAS v4u*)(lds + RT_B + row * RT_BPITCH + 16 * cc) = _t[_i]; } } while (0)
    RT_STAGE_B(0);
    float s = 0.f;
#pragma unroll
    for (int ks = 0; ks < 32; ++ks) { f32x4 lo, hi; pg8::unpack4x2(__builtin_bit_cast(v4u, af[ks]), lo, hi); s += ((lo[0] + lo[1]) + (lo[2] + lo[3])) + ((hi[0] + hi[1]) + (hi[2] + hi[3])); }
    s += __shfl_xor(s, 16); s += __shfl_xor(s, 32);
#define RT_PIN() do { _Pragma("unroll") for (int _k = 0; _k < 32; ++_k) asm volatile("" : "+v"(af[_k])); } while (0)
    RT_PIN();
    const float mean = s * (1.f / D); float q = 0.f;
#pragma unroll
    for (int ks = 0; ks < 32; ++ks) { f32x4 lo, hi; pg8::unpack4x2(__builtin_bit_cast(v4u, af[ks]), lo, hi); lo = lo - mean; hi = hi - mean;
        q += ((lo[0] * lo[0] + lo[1] * lo[1]) + (lo[2] * lo[2] + lo[3] * lo[3])) + ((hi[0] * hi[0] + hi[1] * hi[1]) + (hi[2] * hi[2] + hi[3] * hi[3])); }
    q += __shfl_xor(q, 16); q += __shfl_xor(q, 32);
    const float rstd = 1.f / sqrtf(q * (1.f / D) + LN_EPS);
    RT_PIN();
    __syncthreads();
    { const LAS float* GB = (const LAS float*)(lds + RT_GB);
#pragma unroll
      for (int ks = 0; ks < 32; ++ks) { f32x4 lo, hi; pg8::unpack4x2(__builtin_bit_cast(v4u, af[ks]), lo, hi); const int k = 32 * ks + 8 * fq;
          const f32x4 g0 = *(const LAS f32x4*)(GB + k), g1 = *(const LAS f32x4*)(GB + k + 4), b0 = *(const LAS f32x4*)(GB + D + k), b1 = *(const LAS f32x4*)(GB + D + k + 4);
          const f32x4 o0 = (lo - mean) * rstd * g0 + b0, o1 = (hi - mean) * rstd * g1 + b1; const pg8::u32x4 w = pg8::pack8(o0, o1);
          af[ks] = __builtin_bit_cast(bf16x8, w); *(pg8::u32x4*)(xrow + 32 * ks) = w;
          v2u q8; q8.x = pk4_fp8(o0[0], o0[1], o0[2], o0[3]); q8.y = pk4_fp8(o1[0], o1[1], o1[2], o1[3]); *(v2u*)(XQ + (size_t)(tok0 + fr) * D + 32 * ks + 8 * fq) = q8; } }
    f32x4 acc[3];
#pragma unroll
    for (int nb = 0; nb < 3; ++nb) acc[nb] = (f32x4){0.f, 0.f, 0.f, 0.f};
#define RT_MMA(half) do { _Pragma("unroll") for (int k2 = 0; k2 < 16; ++k2) { _Pragma("unroll") for (int nb = 0; nb < 3; ++nb) { \
        const bf16x8 Bh = *(const LAS bf16x8*)(lds + RT_B + (16 * nb + fr) * RT_BPITCH + 2 * (32 * k2 + 8 * fq)), Bl = *(const LAS bf16x8*)(lds + RT_B + (48 + 16 * nb + fr) * RT_BPITCH + 2 * (32 * k2 + 8 * fq)); \
        acc[nb] = __builtin_amdgcn_mfma_f32_16x16x32_bf16(Bh, af[16 * (half) + k2], acc[nb], 0, 0, 0); acc[nb] = __builtin_amdgcn_mfma_f32_16x16x32_bf16(Bl, af[16 * (half) + k2], acc[nb], 0, 0, 0); } } } while (0)
    RT_MMA(0);
    __syncthreads();
    RT_STAGE_B(1);
    __syncthreads();
    RT_MMA(1);
#undef RT_STAGE_B
#undef RT_MMA
    LAS float* Lg = (LAS float*)(lds + RT_LG);
#pragma unroll
    for (int nb = 0; nb < 3; ++nb)
#pragma unroll
        for (int j = 0; j < 4; ++j) Lg[(16 * wave + fr) * 52 + 16 * nb + 4 * fq + j] = acc[nb][j];
    __syncthreads();
    LAS int* EX = (LAS int*)(lds + RT_EX); LAS float* WT = (LAS float*)(lds + RT_WT); LAS int* LR = (LAS int*)(lds + RT_LR); LAS int* HIST = (LAS int*)(lds + RT_HIST); LAS int* CH = (LAS int*)(lds + RT_CH);
    if (tid < 128) {
        const LAS float* r0 = Lg + tid * 52;
        float lg[4];
#pragma unroll
        for (int g = 0; g < 4; ++g) lg[g] = r0[g] + p.in[I_BRG][l * 4 + g];
        int gs = 0; float gm = lg[0];
#pragma unroll
        for (int g = 1; g < 4; ++g) if (lg[g] > gm) { gm = lg[g]; gs = g; }
        float den = 0.f;
#pragma unroll
        for (int g = 0; g < 4; ++g) den += __expf(lg[g] - gm);
        const float g_w = 1.f / den;
        float el[8];
#pragma unroll
        for (int e = 0; e < 8; ++e) el[e] = r0[4 + 8 * gs + e] + p.in[I_BRE][(l * 4 + gs) * 8 + e];
        int i0 = 0; float v0 = el[0];
#pragma unroll
        for (int e = 1; e < 8; ++e) if (el[e] > v0) { v0 = el[e]; i0 = e; }
        int i1 = -1; float v1 = -3.0e38f;
#pragma unroll
        for (int e = 0; e < 8; ++e) if (e != i0 && el[e] > v1) { v1 = el[e]; i1 = e; }
        const float ex = __expf(v1 - v0);
        EX[2 * tid] = gs * 8 + i0; EX[2 * tid + 1] = gs * 8 + i1; WT[2 * tid] = g_w / (1.f + ex); WT[2 * tid + 1] = g_w * ex / (1.f + ex);
    }
    __syncthreads();
    int my_e = 0, my_lr = 0;
    if (wave < 4) {
        my_e = EX[64 * wave + lane]; int my_cnt = 0;
        const unsigned long long below = (1ull << lane) - 1ull;
        for (int x = 0; x < NEXP; ++x) { const unsigned long long mk = __ballot(my_e == x); if (my_e == x) my_lr = __popcll(mk & below); if (lane == x) my_cnt = __popcll(mk); }
        if (lane < NEXP) CH[wave * NEXP + lane] = my_cnt;
    }
    __syncthreads();
    if (wave < 4) { int before = 0; for (int w = 0; w < wave; ++w) before += CH[w * NEXP + my_e]; LR[64 * wave + lane] = my_lr + before; }
    if (tid < NEXP) HIST[tid] = CH[tid] + CH[NEXP + tid] + CH[2 * NEXP + tid] + CH[3 * NEXP + tid];
    __syncthreads();
    if (tid < NEXP) ((int*)(p.ws + WS_HIST + dofs))[bx * NEXP + tid] = HIST[tid];
    if (tid < 128) { const int t = tid, tok = 128 * bx + t;
        int4 rc; rc.x = EX[2 * t]; rc.y = LR[2 * t]; rc.z = EX[2 * t + 1]; rc.w = LR[2 * t + 1]; ((int4*)(p.ws + WS_TOKREC + dofs))[tok] = rc;
        float2 w; w.x = WT[2 * t]; w.y = WT[2 * t + 1]; ((float2*)(p.ws + WS_TOKW + dofs))[tok] = w; }
    __syncthreads();
}
__device__ __forceinline__ void phase_scatter(const Params& p, int l, LAS unsigned char* lds, int bx, int G, int tid, size_t dofs, int cslot) {
    const int* hist = (const int*)(p.ws + WS_HIST + dofs);
    LAS int* PART = (LAS int*)(lds + RT_PART);
    LAS int* BASE = (LAS int*)(lds + RT_HIST); LAS int* TOT = BASE + 32;
    { const int t = tid, e = t & 31, part = t >> 5; int sb = 0, sa = 0;
      int hv[16];
#pragma unroll
      for (int q = 0; q < 16; ++q) { const int w = part * 16 + q; hv[q] = w < G ? hist[w * NEXP + e] : 0; }
#pragma unroll
      for (int q = 0; q < 16; ++q) { sa += hv[q]; if (part * 16 + q < bx) sb += hv[q]; }
      PART[part * 32 + e] = sb; PART[512 + part * 32 + e] = sa; }
    __syncthreads();
    if (tid < NEXP) { int sb = 0, sa = 0; for (int q = 0; q < 16; ++q) { sb += PART[q * 32 + tid]; sa += PART[512 + q * 32 + tid]; } BASE[tid] = sb; TOT[tid] = sa;
        if (bx == 0) ((unsigned*)(p.ws + WS_CTL))[CW_CNT + 64 * cslot + tid] = (unsigned)sa; }
    __syncthreads();
    if (bx == 0) {
        LAS int* TB = (LAS int*)(lds + RT_PART); unsigned* tbl = (unsigned*)(p.ws + WS_CTL) + CW_TBL + 512 * cslot;
        if (tid == 0) { int t = 0; for (int e = 0; e < NEXP; ++e) { TB[e] = t; t += (TOT[e] + 255) >> 8; } TB[NEXP] = t; }
        __syncthreads();
        if (tid < 33) tbl[tid] = (unsigned)TB[tid]; else if (tid < 65) tbl[tid] = (unsigned)TOT[tid - 33];
        for (int mt = tid; mt < TB[NEXP]; mt += NWAVES * 64) { int e = 0; while (e < NEXP - 1 && mt >= TB[e + 1]) ++e; tbl[65 + mt] = (unsigned)e; }
        __syncthreads();
    }
    if (tid < 128) { const int tok = 128 * bx + tid;
        int4 rc = ((const int4*)(p.ws + WS_TOKREC + dofs))[tok];
        rc.y += BASE[rc.x]; rc.w += BASE[rc.z];
        int* list = (int*)(p.ws + WS_LIST + dofs);
        list[(size_t)rc.x * LCAP + rc.y] = 2 * tok;
        list[(size_t)rc.z * LCAP + rc.w] = 2 * tok + 1;
        ((int4*)(p.ws + WS_TOKREC + dofs))[tok] = rc; }
    __syncthreads();
}


__device__ __forceinline__ void phase_ln2(const Params& p, int l, const LAS int* tb, int gw, int NGW, int lane) {
    const bf16* X1 = (const bf16*)(p.ws + WS_XH1); const bf16* PL = (const bf16*)(p.ws + WS_PP); const unsigned char* YS = p.ws + WS_YS; bf16* XO = (bf16*)(p.ws + WS_XH0);
    const int4* REC = (const int4*)(p.ws + WS_TOKREC); const float2* TW = (const float2*)(p.ws + WS_TOKW);
    const float* g = p.in[I_LN2G] + (size_t)l * D; const float* b = p.in[I_LN2B] + (size_t)l * D;
    f32x4 gg[2][2], bb[2][2];
#pragma unroll
    for (int h = 0; h < 2; ++h)
#pragma unroll
        for (int q = 0; q < 2; ++q) { gg[h][q] = *(const f32x4*)(g + 512 * h + 8 * lane + 4 * q); bb[h][q] = *(const f32x4*)(b + 512 * h + 8 * lane + 4 * q); }
    int m = 2 * gw; if (m >= NTOK) return;
    int4 rc[2]; float2 tw[2];
#pragma unroll
    for (int r = 0; r < 2; ++r) { rc[r] = REC[m + r]; tw[r] = TW[m + r]; }
    for (;;) {
        v4u xv[2][2], pv[2][2]; v2u y0[2][2], y1[2][2]; float w0[2], w1[2];
#pragma unroll
        for (int r = 0; r < 2; ++r) { const size_t s0 = (size_t)(256 * tb[rc[r].x] + rc[r].y) * D, s1 = (size_t)(256 * tb[rc[r].z] + rc[r].w) * D; w0[r] = tw[r].x * (1.f / Y8_SCALE); w1[r] = tw[r].y * (1.f / Y8_SCALE);
#pragma unroll
            for (int h = 0; h < 2; ++h) { const size_t o = (size_t)(m + r) * D + 512 * h + 8 * lane;
                xv[r][h] = *(const v4u*)(X1 + o); pv[r][h] = *(const v4u*)(PL + o); y0[r][h] = *(const v2u*)(YS + s0 + 512 * h + 8 * lane); y1[r][h] = *(const v2u*)(YS + s1 + 512 * h + 8 * lane); } }
        const int mn = m + 2 * NGW; const bool more = mn < NTOK;
        if (more) {
#pragma unroll
            for (int r = 0; r < 2; ++r) { rc[r] = REC[mn + r]; tw[r] = TW[mn + r]; } }
#pragma unroll
        for (int r = 0; r < 2; ++r) {
            f32x4 v[2][2]; float s = 0.f;
#pragma unroll
            for (int h = 0; h < 2; ++h) { f32x4 x0, x1, p0, p1, a0, a1, c0, c1; pg8::unpack4x2(xv[r][h], x0, x1); pg8::unpack4x2(pv[r][h], p0, p1); unpack8_fp8(y0[r][h], a0, a1); unpack8_fp8(y1[r][h], c0, c1);
                v[h][0] = ALPHA * x0 + (w0[r] * a0 + w1[r] * c0) + p0; v[h][1] = ALPHA * x1 + (w0[r] * a1 + w1[r] * c1) + p1;
                s += (v[h][0].x + v[h][0].y) + (v[h][0].z + v[h][0].w) + (v[h][1].x + v[h][1].y) + (v[h][1].z + v[h][1].w); }
            const float mean = wave_sum(s) * (1.f / D); float s2 = 0.f;
#pragma unroll
            for (int h = 0; h < 2; ++h)
#pragma unroll
                for (int q = 0; q < 2; ++q) { v[h][q] = v[h][q] - mean; s2 += (v[h][q].x * v[h][q].x + v[h][q].y * v[h][q].y) + (v[h][q].z * v[h][q].z + v[h][q].w * v[h][q].w); }
            const float rstd = 1.f / sqrtf(wave_sum(s2) * (1.f / D) + LN_EPS);
#pragma unroll
            for (int h = 0; h < 2; ++h) { const f32x4 o0 = v[h][0] * rstd * gg[h][0] + bb[h][0], o1 = v[h][1] * rstd * gg[h][1] + bb[h][1]; const size_t o = (size_t)(m + r) * D + 512 * h + 8 * lane;
                if (l == 1) { *(f32x4*)(p.out + o) = o0; *(f32x4*)(p.out + o + 4) = o1; }
                else { v4u w; w.x = pk2(o0.x, o0.y); w.y = pk2(o0.z, o0.w); w.z = pk2(o1.x, o1.y); w.w = pk2(o1.z, o1.w); *(v4u*)(XO + o) = w; } }
        }
        if (!more) break;
        m = mn;
    }
}

__global__ void __launch_bounds__(NWAVES * 64, 2) mk_fwd(Params p) {
    extern __shared__ __attribute__((aligned(16))) unsigned char lds_raw[];
    LAS unsigned char* lds = (LAS unsigned char*)lds_raw;
    LAS unsigned char* ext = lds + EXT_OFF;
    const int tid = threadIdx.x, wave = __builtin_amdgcn_readfirstlane(tid >> 6); int lane = tid & 63;
int ftid = tid;
#define FRESH_LANE() do { asm volatile("" : "+v"(lane)); ftid = tid; asm volatile("" : "+v"(ftid)); } while (0)
    const int G = gridDim.x, bx = blockIdx.x, vcu = (G % 8 == 0) ? (bx % 8) * (G / 8) + bx / 8 : bx;
    const int gw = bx * NWAVES + wave, NGW = G * NWAVES;
    gu32* ctl = (gu32*)(p.ws + WS_CTL);
    for (int u = tid; u < (LDS_BYTES - EXT_OFF) / 4; u += NWAVES * 64) ((LAS unsigned*)ext)[u] = 0u;
    __syncthreads();
    const int lo = p.ph_lo, hi = p.ph_hi;
    XcdBarrier bar; bar.bar = (unsigned*)ctl + CW_BAR; bar.x = 0; bar.st = nullptr;
    if (hi - lo > 1) bar = xcd_barrier_post((unsigned*)ctl + CW_BAR, (volatile LAS unsigned*)(ext + EXT_MISC) + 8);
#ifndef MK_ONLY
#define MK_ONLY -1
#endif
#define PH_ON(j) (MK_ONLY < 0 || MK_ONLY == (j))
#define IN(k) (lo <= (k) && (k) < hi)
#ifndef PROBE_PH
#define PROBE_PH -1
#endif
    unsigned long long pr_acc = 0ull, pr_t0 = 0ull;
#define PR_BEGIN(j) do { if (PROBE_PH == (j)) pr_t0 = __builtin_amdgcn_s_memrealtime(); } while (0)
#define PR_END(j) do { if (PROBE_PH == (j)) pr_acc += __builtin_amdgcn_s_memrealtime() - pr_t0; } while (0)
#define SEAM(k) do { if (IN(k) && IN((k) + 1)) xcd_barrier(bar); } while (0)
    bf16* XH0 = (bf16*)(p.ws + WS_XH0); bf16* XH1 = (bf16*)(p.ws + WS_XH1);

    PR_BEGIN(8);
    if (PH_ON(0) && IN(0)) {
        FRESH_LANE();
        LAS float* scr = (LAS float*)(lds + wave * TSCR_BYTES);
        phase_cvt_small(p, scr, gw, NGW, lane);
        __syncthreads();
        phase_cvt_moe(p, 0, lds, bx, G, ftid);
        phase_ln0_p(p, gw, NGW, lane);
    }
    SEAM(0);
    PR_END(8);
#define MK_LAYER(l) do { \
        const int b = 1 + 8 * l; \
        unsigned char* sw = p.ws + WS_SMALLW + (size_t)l * SW_LAYER; \
        const unsigned* cnt = (const unsigned*)(p.ws + WS_CTL) + CW_TBL + 512 * l; \
        PR_BEGIN(0); \
        if (PH_ON(1) && IN(b)) { \
            FRESH_LANE(); \
            *(LAS f32x4*)(ext + EXT_BIAS + 16 * ftid) = *(const f32x4*)((const float*)(sw + SW_BIN) + 4 * ftid); \
            __syncthreads(); \
            { pg8::DenseOrder S; S.init(XH0, (const bf16*)(sw + SW_WIN), NTOK, DIN, D, G, bx); \
              pg8::EpiPairZ E{(bf16*)(p.ws + WS_Z), (const LAS float*)(ext + EXT_BIAS)}; \
              pg8::gemm_phase(lds, D, S, E); } \
            { pg8::DenseOrder S; S.init((const bf16*)(p.ws + WS_PB) + (size_t)l * NTOK * DPLE, (const bf16*)(sw + SW_WP), NTOK, D, DPLE, G, bx); \
              pg8::EpiPlain E{(bf16*)(p.ws + WS_PP), D}; \
              pg8::gemm_phase(lds, DPLE, S, E); } \
        } \
        SEAM(b); \
        PR_END(0); \
        PR_BEGIN(1); \
        if (PH_ON(2) && IN(b + 1)) { \
            FRESH_LANE(); \
            phase_mixer(p, l, lds, vcu, G, wave, lane); \
            if (l == 1) { phase_cvt_moe(p, 1, lds, bx, G, ftid); } \
        } \
        SEAM(b + 1); \
        PR_END(1); \
        PR_BEGIN(2); \
        if (PH_ON(3) && IN(b + 2)) { \
            pg8::DenseOrder S; S.init((const bf16*)(p.ws + WS_A2), (const bf16*)(sw + SW_WO), NTOK, D, D, G, bx); \
            pg8::EpiRes E{XH0, XH1}; \
            pg8::gemm_phase(lds, D, S, E); \
        } \
        SEAM(b + 2); \
        PR_END(2); \
        const size_t dofs = 0; \
        PR_BEGIN(3); \
        if (PH_ON(4) && IN(b + 3)) { FRESH_LANE(); phase_route(p, l, lds, bx, wave, lane, ftid, dofs); } \
        SEAM(b + 3); \
        PR_END(3); \
        PR_BEGIN(4); \
        if (PH_ON(4) && IN(b + 4)) { FRESH_LANE(); phase_scatter(p, l, lds, bx, G, ftid, dofs, l + 2 * p.pad); } \
        SEAM(b + 4); \
        PR_END(4); \
        PR_BEGIN(5); \
        if (PH_ON(5) && IN(b + 5)) { \
            FRESH_LANE(); \
            const int T4 = moe_tables(cnt, ext, ftid); \
            pg8::MoeOrder<true> S{(const LAS int*)(ext + EXT_TB), (const LAS int*)(ext + EXT_CT), (const LAS int*)(ext + EXT_T2E), T4, G, vcu, D / 2, (const char*)(p.ws + WS_XQ), (const char*)(p.ws + WS_WUP), (size_t)1024 * 1024, (const int*)(p.ws + WS_LIST)}; \
            pg8::EpiUp E{p.ws + WS_H}; \
            pg8::gemm_phase(lds, D / 2, S, E); \
            { const int rem = (T4 & 255), nl = 256 - rem, j = vcu - rem; \
              pg8::ListOrder SG{(j >= 0) ? 1 : 0, j, -1, 512, D / 2, (const char*)(p.ws + WS_XQ), (const char*)(sw + SW_WG)}; \
              pg8::EpiGate EG{(bf16*)(p.ws + WS_PP), p.in[I_BG] + (size_t)l * D}; \
              (void)nl; pg8::gemm_phase(lds, D / 2, SG, EG); } \
        } \
        SEAM(b + 5); \
        PR_END(5); \
        PR_BEGIN(6); \
        if (PH_ON(6) && IN(b + 6)) { \
            FRESH_LANE(); \
            const int T4 = moe_tables(cnt, ext, ftid); \
            pg8::MoeOrder<false> S{(const LAS int*)(ext + EXT_TB), (const LAS int*)(ext + EXT_CT), (const LAS int*)(ext + EXT_T2E), T4, G, vcu, DEXP / 2, (const char*)(p.ws + WS_H), (const char*)(p.ws + WS_WDN), (size_t)1024 * 512, (const int*)(p.ws + WS_LIST)}; \
            pg8::EpiDown E{p.ws + WS_YS}; \
            pg8::gemm_phase(lds, DEXP / 2, S, E); \
            { const int rem = (T4 & 255), nl = 256 - rem, j = vcu - rem; \
              pg8::ListOrder SG{(j >= 0) ? 1 : 0, nl + j, 2 * nl + vcu, 512, D / 2, (const char*)(p.ws + WS_XQ), (const char*)(sw + SW_WG)}; \
              pg8::EpiGate EG{(bf16*)(p.ws + WS_PP), p.in[I_BG] + (size_t)l * D}; \
              pg8::gemm_phase(lds, D / 2, SG, EG); } \
        } \
        SEAM(b + 6); \
        PR_END(6); \
        PR_BEGIN(7); \
        if (PH_ON(7) && IN(b + 7)) { FRESH_LANE(); (void)moe_tables(cnt, ext, ftid); phase_ln2(p, l, (const LAS int*)(ext + EXT_TB), gw, NGW, lane); } \
        SEAM(b + 7); \
        PR_END(7); \
    } while (0)
    MK_LAYER(0);
    MK_LAYER(1);
#undef MK_LAYER
    if (PROBE_PH >= 0 && bx == 0) { const unsigned long long t0 = __builtin_amdgcn_s_memrealtime(); while (__builtin_amdgcn_s_memrealtime() - t0 < 8ull * pr_acc) __builtin_amdgcn_s_sleep(8); }
#undef IN
#undef SEAM
}
#ifndef MK_FUSED
#define MK_FUSED 1
#endif
#ifndef MK_DUP
#define MK_DUP 0x0
#endif
extern "C" void kernel_launch(void* const* d_in, const int* in_sizes, int n_in, void* d_out, int out_size, void* d_ws, size_t ws_size, hipStream_t stream) {
    static int grid = 0;
    if (grid == 0) {
        if (n_in != 24 || in_sizes[0] != NTOK * D || out_size != NTOK * D || ws_size < WS_END) {
            fprintf(stderr, "kernel_launch: unexpected shapes (n_in %d, in0 %d, out %d, ws %zu < %zu); nothing launched\n", n_in, n_in > 0 ? in_sizes[0] : -1, out_size, ws_size, (size_t)WS_END); grid = -1; return; }
        int dev = 0, cus = 0, per_cu = 0;
        if (hipGetDevice(&dev) != hipSuccess || hipDeviceGetAttribute(&cus, hipDeviceAttributeMultiprocessorCount, dev) != hipSuccess) { grid = -1; return; }
        if (hipFuncSetAttribute((const void*)mk_fwd, hipFuncAttributeMaxDynamicSharedMemorySize, LDS_BYTES) != hipSuccess) { fprintf(stderr, "kernel_launch: hipFuncSetAttribute failed\n"); grid = -1; return; }
        if (hipOccupancyMaxActiveBlocksPerMultiprocessor(&per_cu, (const void*)mk_fwd, NWAVES * 64, LDS_BYTES) != hipSuccess || per_cu < 1) { fprintf(stderr, "kernel_launch: occupancy query says %d blocks per CU\n", per_cu); }
        (void)hipGetLastError();
        grid = cus;
        if (grid != 256) { fprintf(stderr, "kernel_launch: built for 256 CUs, device has %d; nothing launched\n", cus); grid = -1; return; }
    }
    if (grid < 0) return;
    (void)hipMemsetAsync((char*)d_ws + WS_CTL, 0, CTL_BYTES, stream);
    Params p{};
    for (int i = 0; i < 24; ++i) p.in[i] = (const float*)d_in[i];
    p.out = (float*)d_out; p.ws = (unsigned char*)d_ws; p.layer = 0; p.ph_lo = 0; p.ph_hi = 0; p.pad = 0;
#if MK_FUSED
    p.ph_lo = 0; p.ph_hi = N_PHASES;
    hipLaunchKernelGGL(mk_fwd, dim3(grid), dim3(NWAVES * 64), LDS_BYTES, stream, p);
#else
    for (int ph = 0; ph < N_PHASES; ++ph) {
        const int k = ph == 0 ? -1 : (ph - 1) % 8;
        p.ph_lo = ph; p.ph_hi = ph + 1; hipLaunchKernelGGL(mk_fwd, dim3(grid), dim3(NWAVES * 64), LDS_BYTES, stream, p);
        if ((MK_DUP >> ph) & 1) { if (k == 2 || k == 3 || k == 4 || k == 7) p.pad = 1; hipLaunchKernelGGL(mk_fwd, dim3(grid), dim3(NWAVES * 64), LDS_BYTES, stream, p); p.pad = 0; }
    }
#endif
}
```
